# Optimizing an MI355X kernel written in HIP

```python
import jax, jax.numpy as jnp
from jax import lax
import numpy as np

D_MODEL = 1024
BATCH = 2
SEQ = 8192
DEPTH = 4

GRID_W = 64
BLOCK = 128
EPS = 1e-6
ROPE_THETA = 10000.0

A_GROUPS = 8
A_DIM = 64
A_WIDTH = A_GROUPS * A_DIM
B_HEADS = 8
B_KV_HEADS = 2
B_HEAD_DIM = 64
B_WIDTH = B_HEADS * B_HEAD_DIM
C_HEADS = 8
C_NOPE = 64
C_ROPE = 32
C_V = 64
C_Q_RANK = 256
C_KV_RANK = 128
C_WIDTH = C_HEADS * C_V
COLS_A = 2 * A_WIDTH
COLS_B = (B_HEADS + 2 * B_KV_HEADS) * B_HEAD_DIM
COLS_C = C_Q_RANK + C_KV_RANK + C_ROPE
N_BRANCH = 3
COLS_GATE = N_BRANCH * D_MODEL
D_IN = COLS_A + COLS_B + COLS_C + COLS_GATE
PEER_HEADS = 8
PEER_N_KEYS = 128
PEER_N_EXPERTS = PEER_N_KEYS * PEER_N_KEYS
PEER_D_KEY = 256
PEER_TOPK = 16
PEER_CHUNK = 128

kernel_name = 'hybrid_gated_mixers_peer_encoder'


def rms_norm(x, g):
    xf = x.astype(jnp.float32)
    y = xf * lax.rsqrt(jnp.mean(xf * xf, axis=-1, keepdims=True) + EPS)
    return (y * g.astype(jnp.float32)).astype(x.dtype)


def modulate(x, shift, scale):
    return x * (1 + scale[:, None, :]) + shift[:, None, :]


def axial_rope_angles(seq, d_rot):
    rows = seq // GRID_W
    row = jnp.repeat(jnp.arange(rows, dtype=jnp.float32), GRID_W)
    col = jnp.tile(jnp.arange(GRID_W, dtype=jnp.float32), rows)
    half = d_rot // 2
    freq = ROPE_THETA ** (-jnp.arange(0, half, 2, dtype=jnp.float32) / half)
    ang = jnp.concatenate([row[:, None] * freq, col[:, None] * freq], axis=-1)
    return jnp.cos(ang), jnp.sin(ang)


def apply_rope(x, cos, sin):
    xf = x.astype(jnp.float32).reshape(*x.shape[:-1], -1, 2)
    x1, x2 = xf[..., 0], xf[..., 1]
    c = cos[None, :, None, :]
    s = sin[None, :, None, :]
    out = jnp.stack([x1 * c - x2 * s, x1 * s + x2 * c], axis=-1).reshape(x.shape)
    return out.astype(x.dtype)


def block_attention(q, k, v):
    b, s, hq, dk = q.shape
    hkv = k.shape[2]
    grp = hq // hkv
    scale = dk ** -0.5
    qb = q.reshape(b, s // BLOCK, BLOCK, hkv, grp, dk).transpose(1, 0, 2, 3, 4, 5)

    def one_block(qblk):
        sc = jnp.einsum('bqkgd,bskd->bkgqs', qblk, k, preferred_element_type=jnp.float32) * scale
        p = jax.nn.softmax(sc, axis=-1)
        return jnp.einsum('bkgqs,bskd->bqkgd', p.astype(v.dtype), v)

    out = lax.map(one_block, qb)
    return out.transpose(1, 0, 2, 3, 4, 5).reshape(b, s, hq * v.shape[-1])


def spatial_gating_branch(za, v_gain, w_s, b_s):
    b, s, _ = za.shape
    z = jax.nn.gelu(za)
    u, v = jnp.split(z, 2, axis=-1)
    v = rms_norm(v, v_gain).reshape(b, s // BLOCK, BLOCK, A_GROUPS, A_DIM)
    mixed = jnp.einsum('gpq,bcqgd->bcpgd', w_s, v) + b_s.T[None, None, :, :, None]
    return u * mixed.reshape(b, s, A_WIDTH)


def gqa_branch(zb, q_gain, k_gain, cos, sin):
    b, s, _ = zb.shape
    q, k, v = jnp.split(zb, [B_HEADS * B_HEAD_DIM, (B_HEADS + B_KV_HEADS) * B_HEAD_DIM], axis=-1)
    q = apply_rope(rms_norm(q.reshape(b, s, B_HEADS, B_HEAD_DIM), q_gain), cos, sin)
    k = apply_rope(rms_norm(k.reshape(b, s, B_KV_HEADS, B_HEAD_DIM), k_gain), cos, sin)
    v = v.reshape(b, s, B_KV_HEADS, B_HEAD_DIM)
    return block_attention(q, k, v)


def mla_branch(zc, cq_gain, w_uq, ckv_gain, w_ukv, cos, sin):
    b, s, _ = zc.shape
    c_q, c_kv, k_rope = jnp.split(zc, [C_Q_RANK, C_Q_RANK + C_KV_RANK], axis=-1)
    q = (rms_norm(c_q, cq_gain) @ w_uq).reshape(b, s, C_HEADS, C_NOPE + C_ROPE)
    q_nope, q_rope = jnp.split(q, [C_NOPE], axis=-1)
    kv = (rms_norm(c_kv, ckv_gain) @ w_ukv).reshape(b, s, C_HEADS, C_NOPE + C_V)
    k_nope, v = jnp.split(kv, [C_NOPE], axis=-1)
    k_rope = apply_rope(k_rope[:, :, None, :], cos, sin)
    q = jnp.concatenate([q_nope, apply_rope(q_rope, cos, sin)], axis=-1)
    k = jnp.concatenate([k_nope, jnp.broadcast_to(k_rope, (b, s, C_HEADS, C_ROPE))], axis=-1)
    return block_attention(q, k, v)


def peer_ffn(h, w_query, sub_keys, u_table, v_table):
    b, s, d = h.shape
    t = h.reshape(-1, PEER_CHUNK, d)

    def one_chunk(xc):
        q = (xc @ w_query).reshape(PEER_CHUNK, PEER_HEADS, 2, PEER_D_KEY // 2)
        sc = jnp.einsum('thpd,hpkd->thpk', q, sub_keys, preferred_element_type=jnp.float32)
        top_v, top_i = lax.top_k(sc, PEER_TOPK)
        cand_v = (top_v[:, :, 0, :, None] + top_v[:, :, 1, None, :]).reshape(PEER_CHUNK, PEER_HEADS, -1)
        cand_i = (top_i[:, :, 0, :, None] * PEER_N_KEYS + top_i[:, :, 1, None, :]).reshape(PEER_CHUNK, PEER_HEADS, -1)
        best_v, best_pos = lax.top_k(cand_v, PEER_TOPK)
        ids = jnp.take_along_axis(cand_i, best_pos, axis=-1)
        g = jax.nn.softmax(best_v, axis=-1)
        act = jax.nn.gelu(jnp.einsum('thkd,td->thk', u_table[ids], xc))
        w = (g * act.astype(jnp.float32)).astype(xc.dtype)
        return jnp.einsum('thk,thkd->td', w, v_table[ids])

    return lax.map(one_chunk, t).reshape(b, s, d)


def setup_inputs(seed: int = 0) -> dict:
    key = jax.random.key(seed)
    ks = jax.random.split(key, 25)
    L, D = DEPTH, D_MODEL

    def nrm(k, shape, scale):
        return jax.random.normal(k, shape, jnp.float32) * scale

    def gain(k, shape):
        return 1.0 + 0.02 * jax.random.normal(k, shape, jnp.float32)

    return {
        'x': nrm(ks[0], (BATCH, SEQ, D), 1.0),
        'c': nrm(ks[1], (BATCH, D), 1.0),
        'w_ada': nrm(ks[2], (L, D, 6 * D), 0.5 * D ** -0.5),
        'b_ada': nrm(ks[3], (L, 6 * D), 0.02),
        'norm1_gain': gain(ks[4], (L, D)),
        'w_in': nrm(ks[5], (L, D, D_IN), D ** -0.5),
        'a_v_gain': gain(ks[6], (L, A_WIDTH)),
        'a_w_s': nrm(ks[7], (L, A_GROUPS, BLOCK, BLOCK), 0.5 * BLOCK ** -0.5),
        'a_b_s': gain(ks[8], (L, A_GROUPS, BLOCK)),
        'b_q_gain': gain(ks[9], (L, B_HEAD_DIM)),
        'b_k_gain': gain(ks[10], (L, B_HEAD_DIM)),
        'c_q_gain': gain(ks[11], (L, C_Q_RANK)),
        'c_w_uq': nrm(ks[12], (L, C_Q_RANK, C_HEADS * (C_NOPE + C_ROPE)), C_Q_RANK ** -0.5),
        'c_kv_gain': gain(ks[13], (L, C_KV_RANK)),
        'c_w_ukv': nrm(ks[14], (L, C_KV_RANK, C_HEADS * (C_NOPE + C_V)), C_KV_RANK ** -0.5),
        'w_pa': nrm(ks[15], (L, A_WIDTH, D), A_WIDTH ** -0.5),
        'w_pb': nrm(ks[16], (L, B_WIDTH, D), B_WIDTH ** -0.5),
        'w_pc': nrm(ks[17], (L, C_WIDTH, D), C_WIDTH ** -0.5),
        'w_out': nrm(ks[18], (L, D, D), D ** -0.5),
        'norm2_gain': gain(ks[19], (L, D)),
        'peer_w_query': nrm(ks[20], (L, D, PEER_HEADS * PEER_D_KEY), D ** -0.5),
        'peer_sub_keys': nrm(ks[21], (L, PEER_HEADS, 2, PEER_N_KEYS, PEER_D_KEY // 2), (PEER_D_KEY // 2) ** -0.5),
        'peer_u': nrm(ks[22], (L, PEER_N_EXPERTS, D), D ** -0.5),
        'peer_v': nrm(ks[23], (L, PEER_N_EXPERTS, D), 0.5),
        'final_gain': gain(ks[24], (D,)),
    }


def reference(x, c, w_ada, b_ada, norm1_gain, w_in, a_v_gain, a_w_s, a_b_s, b_q_gain, b_k_gain,
              c_q_gain, c_w_uq, c_kv_gain, c_w_ukv, w_pa, w_pb, w_pc, w_out, norm2_gain,
              peer_w_query, peer_sub_keys, peer_u, peer_v, final_gain):
    b, seq, d = x.shape
    cos_b, sin_b = axial_rope_angles(seq, B_HEAD_DIM)
    cos_c, sin_c = axial_rope_angles(seq, C_ROPE)
    cos_b, sin_b, cos_c, sin_c = [t.astype(x.dtype) for t in (cos_b, sin_b, cos_c, sin_c)]
    c_act = jax.nn.silu(c)
    for l in range(DEPTH):
        mod = c_act @ w_ada[l] + b_ada[l]
        sh1, sc1, g1, sh2, sc2, g2 = jnp.split(mod, 6, axis=-1)
        h = modulate(rms_norm(x, norm1_gain[l]), sh1, sc1)
        z = h @ w_in[l]
        za, zb, zc, zg = jnp.split(z, [COLS_A, COLS_A + COLS_B, COLS_A + COLS_B + COLS_C], axis=-1)
        ya = spatial_gating_branch(za, a_v_gain[l], a_w_s[l], a_b_s[l])
        yb = gqa_branch(zb, b_q_gain[l], b_k_gain[l], cos_b, sin_b)
        yc = mla_branch(zc, c_q_gain[l], c_w_uq[l], c_kv_gain[l], c_w_ukv[l], cos_c, sin_c)
        gates = jax.nn.sigmoid(zg.astype(jnp.float32)).astype(x.dtype).reshape(b, seq, N_BRANCH, d)
        merged = (gates[:, :, 0, :] * (ya @ w_pa[l])
                  + gates[:, :, 1, :] * (yb @ w_pb[l])
                  + gates[:, :, 2, :] * (yc @ w_pc[l]))
        x = x + g1[:, None, :] * (merged @ w_out[l])
        h2 = modulate(rms_norm(x, norm2_gain[l]), sh2, sc2)
        x = x + g2[:, None, :] * peer_ffn(h2, peer_w_query[l], peer_sub_keys[l], peer_u[l], peer_v[l])
    return rms_norm(x, final_gain)
```

```cpp
#include <hip/hip_runtime.h>
#include <cstdio>
#include <cstdint>

#ifndef PROBE_PHASE
#define PROBE_PHASE -1
#endif
#ifndef PROBE_N
#define PROBE_N 2
#endif
#define LAS __attribute__((address_space(3)))
#define GAS __attribute__((address_space(1)))
typedef float f32x2_t __attribute__((ext_vector_type(2)));
typedef __bf16 bf16x2_t __attribute__((ext_vector_type(2)));
typedef float f32x16 __attribute__((ext_vector_type(16)));
typedef short s16x4 __attribute__((ext_vector_type(4)));
typedef unsigned u32x2 __attribute__((ext_vector_type(2)));

constexpr int MTOK = 16384, DM = 1024, NLAYER = 4, SEQ = 8192, NBATCH = 2;
constexpr int NZ = 5376;
constexpr int ZC_U = 0, ZC_V = 512, ZC_QB = 1024, ZC_KB = 1536, ZC_VB = 1664, ZC_CQ = 1792, ZC_CKV = 2048, ZC_KR = 2176, ZC_G = 2208, ZC_END = 5280;
constexpr float EPS = 1e-6f;
constexpr int MODS = 6144;

__device__ __forceinline__ unsigned cvtpk(float lo, float hi) { f32x2_t v = {lo, hi}; bf16x2_t b = __builtin_convertvector(v, bf16x2_t); return __builtin_bit_cast(unsigned, b); }
__device__ __forceinline__ float bf_lo(unsigned u) { return __uint_as_float(u << 16); }
__device__ __forceinline__ float bf_hi(unsigned u) { return __uint_as_float(u & 0xffff0000u); }
__device__ __forceinline__ float bf2f(unsigned short b) { return __uint_as_float(((unsigned)b) << 16); }
__device__ __forceinline__ unsigned short f2bf(float f) { return (unsigned short)(cvtpk(f, 0.f) & 0xffffu); }
__device__ __forceinline__ float gelu_tanh(float x) {
    const float y = x * (1.5957691216057308f + 0.07135481627f * x * x);
    const float e = __builtin_amdgcn_exp2f(-1.4426950408889634f * y);
    return x * __builtin_amdgcn_rcpf(1.0f + e);
}
__device__ __forceinline__ float sigmoidf_(float x) { const float e = __builtin_amdgcn_exp2f(-1.4426950408889634f * x); return __builtin_amdgcn_rcpf(1.0f + e); }
namespace pg8 {
#define PG8_LAS __attribute__((address_space(3)))
typedef unsigned short bf16_t;
typedef short bf16x8 __attribute__((ext_vector_type(8)));
typedef float f32x4 __attribute__((ext_vector_type(4)));
typedef unsigned u32x4 __attribute__((ext_vector_type(4)));
constexpr int BM = 256, BK = 64, HALF = 128, HTB = HALF * BK * 2  , STAGE_BYTES = 8 * HTB, NXCD = 8, WGM = 8;

__host__ __device__ __forceinline__ int lds_byte(int r, int c) { const int st = (r >> 4) * 2 + (c >> 5), rr = r & 15, cc = c & 31, ob = rr * 64 + cc * 2; return st * 1024 + (ob ^ (((ob >> 9) & 1) << 5)); }
__host__ __device__ __forceinline__ void stage_rc(int b, int& R, int& C) { const int st = b / 1024, sb = b % 1024, swz = sb ^ (((sb >> 9) & 1) << 5); R = (st >> 1) * 16 + swz / 64; C = (st & 1) * 32 + (swz % 64) / 2; }
__host__ __device__ __forceinline__ int perm32(int rho) { const int n = rho >> 4, i = rho & 15; return 8 * (i >> 2) + 4 * n + (i & 3); }

struct Unit { int pm, pn; };
struct Gemm { const bf16_t* A; const bf16_t* Bt; int M, N, K; };

struct StaticOrder {
    int nM, nN, nwg, G, c;
    __host__ __device__ void init(int M, int N, int G_, int c_) { nM = M / BM; nN = N / BM; nwg = nM * nN; G = G_; c = c_; }
    __host__ __device__ bool next(int i, Unit& u) const {
        const long L = (long)i * G + c; if (L >= nwg) return false;
        int wgid = (int)L; { const int q = nwg / NXCD, r = nwg % NXCD, xcd = wgid % NXCD, off = wgid / NXCD; wgid = (xcd < r ? xcd * (q + 1) : r * (q + 1) + (xcd - r) * q) + off; }
        const int nig = WGM * nN, gid = wgid / nig, fm = gid * WGM, gsz = (nM - fm) < WGM ? (nM - fm) : WGM;
        u.pm = fm + ((wgid % nig) % gsz); u.pn = (wgid % nig) / gsz; return true;
    }
    __device__ __forceinline__ void a_ready(const Unit&) const {}
    __device__ __forceinline__ void done(const Unit&) const {}
};
__device__ __forceinline__ u32x4 pack8(f32x4 v0, f32x4 v1) { u32x4 w; w.x = cvtpk(v0[0], v0[1]); w.y = cvtpk(v0[2], v0[3]); w.z = cvtpk(v1[0], v1[1]); w.w = cvtpk(v1[2], v1[3]); return w; }

__device__ __forceinline__ unsigned pack4_fp8e(float a, float b, float c, float d) { int p = 0; p = __builtin_amdgcn_cvt_pk_fp8_f32(a, b, p, false); p = __builtin_amdgcn_cvt_pk_fp8_f32(c, d, p, true); return (unsigned)p; }
__device__ __forceinline__ float ub0(unsigned w) { return (float)(w & 255u); }
__device__ __forceinline__ float ub1(unsigned w) { return (float)((w >> 8) & 255u); }
__device__ __forceinline__ float ub2(unsigned w) { return (float)((w >> 16) & 255u); }
__device__ __forceinline__ float ub3(unsigned w) { return (float)(w >> 24); }
__device__ __forceinline__ unsigned pack4_u8(float a, float b, float c, float d) {
    const unsigned qa = (unsigned)__builtin_fmaxf(__builtin_rintf(a * 255.f), 1.f), qb = (unsigned)__builtin_fmaxf(__builtin_rintf(b * 255.f), 1.f);
    const unsigned qc = (unsigned)__builtin_fmaxf(__builtin_rintf(c * 255.f), 1.f), qd = (unsigned)__builtin_fmaxf(__builtin_rintf(d * 255.f), 1.f);
    return qa | (qb << 8) | (qc << 16) | (qd << 24);
}
struct EpiZ {
    static constexpr bool PERM = true, AFTER_DRAIN = false, MID = false;
    bf16_t* Z; unsigned char* G8; float osc;
    __device__ __forceinline__ void operator()(const f32x4 (&acc)[2][2][4][2], const Unit& u, int wr, int wc, int fr, int fq) const {
        const int row0 = u.pm * BM + wr * 64 + fr;
#pragma unroll
        for (int bj = 0; bj < 2; ++bj) {
            const int col0 = u.pn * BM + bj * HALF + wc * 32 + 8 * fq;
            const int mode = col0 < ZC_QB ? 1 : (col0 >= ZC_G ? 2 : 0);
#pragma unroll
            for (int ai = 0; ai < 2; ++ai)
#pragma unroll
                for (int m = 0; m < 4; ++m) {
                    f32x4 v0 = acc[ai][bj][m][0] * osc, v1 = acc[ai][bj][m][1] * osc;
                    if (mode == 1) {
#pragma unroll
                        for (int j = 0; j < 4; ++j) { v0[j] = gelu_tanh(v0[j]); v1[j] = gelu_tanh(v1[j]); }
                    } else if (mode == 2) {
#pragma unroll
                        for (int j = 0; j < 4; ++j) { v0[j] = sigmoidf_(v0[j]); v1[j] = sigmoidf_(v1[j]); }
                        if (col0 < ZC_END) { u32x2 w; w.x = pack4_u8(v0[0], v0[1], v0[2], v0[3]); w.y = pack4_u8(v1[0], v1[1], v1[2], v1[3]);
                            *(u32x2*)(G8 + (size_t)(row0 + ai * HALF + m * 16) * 3072 + (col0 - ZC_G)) = w; }
                        continue;
                    }
                    *(u32x4*)(Z + (size_t)(row0 + ai * HALF + m * 16) * NZ + col0) = pack8(v0, v1);
                }
        }
    }
};

struct EpiPlain {
    static constexpr bool PERM = true, AFTER_DRAIN = false, MID = false;
    bf16_t* O; int ldc;
    __device__ __forceinline__ void operator()(const f32x4 (&acc)[2][2][4][2], const Unit& u, int wr, int wc, int fr, int fq) const {
        const int row0 = u.pm * BM + wr * 64 + fr;
#pragma unroll
        for (int bj = 0; bj < 2; ++bj) {
            const int col0 = u.pn * BM + bj * HALF + wc * 32 + 8 * fq;
#pragma unroll
            for (int ai = 0; ai < 2; ++ai)
#pragma unroll
                for (int m = 0; m < 4; ++m)
                    *(u32x4*)(O + (size_t)(row0 + ai * HALF + m * 16) * ldc + col0) = pack8(acc[ai][bj][m][0], acc[ai][bj][m][1]);
        }
    }
};

struct EpiQC {
    static constexpr bool PERM = true, AFTER_DRAIN = false, MID = false;
    bf16_t* QC; const float* cosC; const float* sinC;
    __device__ __forceinline__ void operator()(const f32x4 (&acc)[2][2][4][2], const Unit& u, int wr, int wc, int fr, int fq) const {
        const int row0 = u.pm * BM + wr * 64 + fr;
#pragma unroll
        for (int bj = 0; bj < 2; ++bj) {
            const int col0 = u.pn * BM + bj * HALF + wc * 32 + 8 * fq;
            const int e0 = col0 % 96;
#pragma unroll
            for (int ai = 0; ai < 2; ++ai)
#pragma unroll
                for (int m = 0; m < 4; ++m) {
                    const int row = row0 + ai * HALF + m * 16;
                    f32x4 v0 = acc[ai][bj][m][0] * (0.10206207261596575f * 1.4426950408889634f), v1 = acc[ai][bj][m][1] * (0.10206207261596575f * 1.4426950408889634f);
                    if (e0 >= 64) {
                        const int pos = row & (SEQ - 1), i0 = (e0 - 64) >> 1;
                        const f32x4 c = *(const f32x4*)(cosC + pos * 16 + i0), s = *(const f32x4*)(sinC + pos * 16 + i0);
                        const f32x4 a0 = v0, a1 = v1;
                        v0[0] = a0[0] * c[0] - a0[1] * s[0]; v0[1] = a0[0] * s[0] + a0[1] * c[0];
                        v0[2] = a0[2] * c[1] - a0[3] * s[1]; v0[3] = a0[2] * s[1] + a0[3] * c[1];
                        v1[0] = a1[0] * c[2] - a1[1] * s[2]; v1[1] = a1[0] * s[2] + a1[1] * c[2];
                        v1[2] = a1[2] * c[3] - a1[3] * s[3]; v1[3] = a1[2] * s[3] + a1[3] * c[3];
                    }
                    *(u32x4*)(QC + (size_t)row * 768 + col0) = pack8(v0, v1);
                }
        }
    }
};

struct EpiKV {
    static constexpr bool PERM = true, AFTER_DRAIN = false, MID = false;
    bf16_t* KC; bf16_t* VC;
    __device__ __forceinline__ void operator()(const f32x4 (&acc)[2][2][4][2], const Unit& u, int wr, int wc, int fr, int fq) const {
        const int row0 = u.pm * BM + wr * 64 + fr;
#pragma unroll
        for (int bj = 0; bj < 2; ++bj) {
            const int col0 = u.pn * BM + bj * HALF + wc * 32 + 8 * fq;
            const int h = col0 >> 7, e0 = col0 & 127;
            bf16_t* base = (e0 < 64) ? (KC + h * 96 + e0) : (VC + h * 64 + (e0 - 64));
            const int ld = (e0 < 64) ? 768 : 512;
#pragma unroll
            for (int ai = 0; ai < 2; ++ai)
#pragma unroll
                for (int m = 0; m < 4; ++m)
                    *(u32x4*)(base + (size_t)(row0 + ai * HALF + m * 16) * ld) = pack8(acc[ai][bj][m][0], acc[ai][bj][m][1]);
        }
    }
};

struct EpiGate {
    static constexpr bool PERM = true, AFTER_DRAIN = false, MID = true;
    static constexpr int MID_T0 = 4, MID_T1 = 8;
    const unsigned char* G8; bf16_t* MB;
    __device__ __forceinline__ void mid(f32x4 (&acc)[2][2][4][2], const Unit& u, int wr, int wc, int fr, int fq, int t) const {
        int row0 = u.pm * BM + wr * 64 + fr; asm volatile("" : "+v"(row0));
        const int gb = (t == MID_T0) ? 0 : 1024;
#pragma unroll
        for (int bj = 0; bj < 2; ++bj) {
            const int col0 = u.pn * BM + bj * HALF + wc * 32 + 8 * fq;
#pragma unroll
            for (int ai = 0; ai < 2; ++ai)
#pragma unroll
                for (int m = 0; m < 4; ++m) {
                    const unsigned char* gp = G8 + (size_t)(row0 + ai * HALF + m * 16) * 3072 + gb + col0;
                    const u32x2 gn = *(const u32x2*)gp, gd = *(const u32x2*)(gp + 1024);
                    f32x4& v0 = acc[ai][bj][m][0]; f32x4& v1 = acc[ai][bj][m][1];
                    v0[0] *= ub0(gn.x) * __builtin_amdgcn_rcpf(ub0(gd.x)); v0[1] *= ub1(gn.x) * __builtin_amdgcn_rcpf(ub1(gd.x));
                    v0[2] *= ub2(gn.x) * __builtin_amdgcn_rcpf(ub2(gd.x)); v0[3] *= ub3(gn.x) * __builtin_amdgcn_rcpf(ub3(gd.x));
                    v1[0] *= ub0(gn.y) * __builtin_amdgcn_rcpf(ub0(gd.y)); v1[1] *= ub1(gn.y) * __builtin_amdgcn_rcpf(ub1(gd.y));
                    v1[2] *= ub2(gn.y) * __builtin_amdgcn_rcpf(ub2(gd.y)); v1[3] *= ub3(gn.y) * __builtin_amdgcn_rcpf(ub3(gd.y));
                    asm volatile("" ::: "memory");
                }
        }
    }
    __device__ __forceinline__ void operator()(const f32x4 (&acc)[2][2][4][2], const Unit& u, int wr, int wc, int fr, int fq) const {
        const int row0 = u.pm * BM + wr * 64 + fr;
#pragma unroll
        for (int bj = 0; bj < 2; ++bj) {
            const int col0 = u.pn * BM + bj * HALF + wc * 32 + 8 * fq;
#pragma unroll
            for (int ai = 0; ai < 2; ++ai)
#pragma unroll
                for (int m = 0; m < 4; ++m) {
                    const int row = row0 + ai * HALF + m * 16;
                    const u32x2 g = *(const u32x2*)(G8 + (size_t)row * 3072 + 2048 + col0);
                    f32x4 v0 = acc[ai][bj][m][0] * (1.f / (255.f * 32.f)), v1 = acc[ai][bj][m][1] * (1.f / (255.f * 32.f));
                    v0[0] *= ub0(g.x); v0[1] *= ub1(g.x); v0[2] *= ub2(g.x); v0[3] *= ub3(g.x);
                    v1[0] *= ub0(g.y); v1[1] *= ub1(g.y); v1[2] *= ub2(g.y); v1[3] *= ub3(g.y);
                    { u32x2 w8; w8.x = pack4_fp8e(v0[0], v0[1], v0[2], v0[3]); w8.y = pack4_fp8e(v1[0], v1[1], v1[2], v1[3]); *(u32x2*)((unsigned char*)MB + (size_t)row * 1024 + col0) = w8; }
                }
        }
    }
};

struct EpiOut {
    static constexpr bool PERM = true, AFTER_DRAIN = false, MID = false;
    const float* Xin; bf16_t* X; const float* g1; float osc;
    __device__ __forceinline__ void operator()(const f32x4 (&acc)[2][2][4][2], const Unit& u, int wr, int wc, int fr, int fq) const {
        const int row0 = u.pm * BM + wr * 64 + fr;
        const int b = (u.pm * BM) >> 13;
#pragma unroll
        for (int bj = 0; bj < 2; ++bj) {
            const int col0 = u.pn * BM + bj * HALF + wc * 32 + 8 * fq;
            const f32x4 ga = *(const f32x4*)(g1 + b * MODS + col0), gb = *(const f32x4*)(g1 + b * MODS + col0 + 4);
#pragma unroll
            for (int ai = 0; ai < 2; ++ai)
#pragma unroll
                for (int m = 0; m < 4; ++m) {
                    const size_t xo = (size_t)(row0 + ai * HALF + m * 16) * 1024 + col0; bf16_t* xp = X + xo;
                    f32x4 x0, x1;
                    if (Xin) { x0 = *(const f32x4*)(Xin + xo); x1 = *(const f32x4*)(Xin + xo + 4); }
                    else { const u32x4 w = *(const u32x4*)xp; x0 = (f32x4){bf_lo(w.x), bf_hi(w.x), bf_lo(w.y), bf_hi(w.y)}; x1 = (f32x4){bf_lo(w.z), bf_hi(w.z), bf_lo(w.w), bf_hi(w.w)}; }
                    x0 += ga * (acc[ai][bj][m][0] * osc); x1 += gb * (acc[ai][bj][m][1] * osc);
                    *(u32x4*)xp = pack8(x0, x1);
                }
        }
    }
};
template <class Epi, class Sched, bool ALIGN_EPI = false, bool SP2 = false, bool FP8 = false>
__device__ __forceinline__ void gemm_phase(PG8_LAS unsigned char* lds, const Gemm g, const Sched& S, const Epi& E) {
    int tid = threadIdx.x; asm volatile("" : "+v"(tid));
    const int wid = __builtin_amdgcn_readfirstlane(tid >> 6), lane = tid & 63, wr = wid >> 2, wc = wid & 3, fr = lane & 15, fq = lane >> 4;
    const int K = g.K, nt = K / BK;
    unsigned voffA[2], voffB[2];
#pragma unroll
    for (int i = 0; i < 2; ++i) { int R, C; stage_rc(tid * 16 + i * 8192, R, C); const int Rb = Epi::PERM ? ((R & ~31) + perm32(R & 31)) : R;
        voffA[i] = (unsigned)(R * K + C) * 2u; voffB[i] = (unsigned)(Rb * K + C) * 2u; }
    const size_t kstep = (size_t)(BK * 2);
    const size_t hstep = (size_t)HALF * K * 2;
    const size_t tstep = 2 * hstep;
    const unsigned ldsw = (unsigned)wid * 1024u;
    const int aoff = lds_byte(wr * 64 + fr, fq * 8), boff = lds_byte(wc * 32 + fr, fq * 8);
#define PG8_SA(b, h) (((b) * 2 + (h)) * HTB)
#define PG8_SB(b, h) ((4 + (b) * 2 + (h)) * HTB)
#define PG8_STAGE(bufoff, gbase, voff) do { _Pragma("unroll") for (int _i = 0; _i < 2; ++_i) \
        __builtin_amdgcn_global_load_lds((const unsigned*)((const char*)(gbase) + (voff)[_i]), (PG8_LAS unsigned*)(lds + (bufoff) + ldsw + _i * 8192), 16, 0, 0); } while (0)
#define PG8_LDA(dst, b, h) do { _Pragma("unroll") for (int m = 0; m < 4; ++m) _Pragma("unroll") for (int k = 0; k < 2; ++k) dst[m][k] = *(const PG8_LAS bf16x8*)(lds + PG8_SA(b, h) + aoff + m * 2048 + k * 1024); } while (0)
#define PG8_LDB(dst, b, h) do { _Pragma("unroll") for (int n = 0; n < 2; ++n) _Pragma("unroll") for (int k = 0; k < 2; ++k) dst[n][k] = *(const PG8_LAS bf16x8*)(lds + PG8_SB(b, h) + boff + n * 2048 + k * 1024); } while (0)
#define PG8_MMA(ai, bj, At, Bt) do { __builtin_amdgcn_s_setprio(1); _Pragma("unroll") for (int m = 0; m < 4; ++m) _Pragma("unroll") for (int n = 0; n < 2; ++n) { \
        if constexpr (FP8) { typedef int v8i_ __attribute__((ext_vector_type(8))); typedef int v4i_ __attribute__((ext_vector_type(4))); \
            const v4i_ b0_ = __builtin_bit_cast(v4i_, Bt[n][0]), b1_ = __builtin_bit_cast(v4i_, Bt[n][1]), a0_ = __builtin_bit_cast(v4i_, At[m][0]), a1_ = __builtin_bit_cast(v4i_, At[m][1]); \
            const v8i_ bo_ = {b0_[0], b0_[1], b0_[2], b0_[3], b1_[0], b1_[1], b1_[2], b1_[3]}, ao_ = {a0_[0], a0_[1], a0_[2], a0_[3], a1_[0], a1_[1], a1_[2], a1_[3]}; \
            asm volatile("v_mfma_scale_f32_16x16x128_f8f6f4 %0, %1, %2, %0, %3, %3 op_sel_hi:[0,0,0]" : "+v"(acc[ai][bj][m][n]) : "v"(bo_), "v"(ao_), "v"(0x7f7f7f7f)); } \
        else { _Pragma("unroll") for (int k = 0; k < 2; ++k) acc[ai][bj][m][n] = __builtin_amdgcn_mfma_f32_16x16x32_bf16(Bt[n][k], At[m][k], acc[ai][bj][m][n], 0, 0, 0); } } \
        __builtin_amdgcn_s_setprio(0); } while (0)
#define PG8_WAIT_V(n) asm volatile("s_waitcnt vmcnt(" #n ")" ::: "memory")
#define PG8_WAIT_L(n) asm volatile("s_waitcnt lgkmcnt(" #n ")" ::: "memory")
#define PG8_BAR __builtin_amdgcn_s_barrier()
#define PG8_SCHED __builtin_amdgcn_sched_barrier(0)
    Unit cur, nxt; int ui = 0;
    if (!S.next(0, cur)) return;
    f32x4 acc[2][2][4][2];
#pragma unroll
    for (int a = 0; a < 2; ++a)
#pragma unroll
        for (int b = 0; b < 2; ++b)
#pragma unroll
            for (int m = 0; m < 4; ++m)
#pragma unroll
                for (int n = 0; n < 2; ++n) acc[a][b][m][n] = (f32x4){0.f, 0.f, 0.f, 0.f};
    bf16x8 At[4][2], B0[2][2], B1[2][2];
    const char* cA = (const char*)g.A + (size_t)cur.pm * tstep; const char* cB = (const char*)g.Bt + (size_t)cur.pn * tstep;
    S.a_ready(cur);
    if constexpr (SP2) {
        PG8_STAGE(PG8_SB(0, 0), cB, voffB); PG8_STAGE(PG8_SB(0, 1), cB + hstep, voffB); PG8_STAGE(PG8_SA(0, 0), cA, voffA); PG8_STAGE(PG8_SA(0, 1), cA + hstep, voffA);
        if (wr == 1) PG8_BAR;
        PG8_WAIT_V(2); PG8_BAR;
        PG8_STAGE(PG8_SB(1, 0), cB + kstep, voffB); PG8_STAGE(PG8_SA(1, 0), cA + kstep, voffA); PG8_STAGE(PG8_SB(1, 1), cB + hstep + kstep, voffB);
        PG8_WAIT_V(6); PG8_BAR;
    } else {
        PG8_STAGE(PG8_SB(0, 0), cB, voffB); PG8_STAGE(PG8_SA(0, 0), cA, voffA); PG8_STAGE(PG8_SB(0, 1), cB + hstep, voffB); PG8_STAGE(PG8_SA(0, 1), cA + hstep, voffA);
        if (wr == 1) PG8_BAR;
        PG8_WAIT_V(4); PG8_BAR;
        PG8_STAGE(PG8_SB(1, 0), cB + kstep, voffB); PG8_STAGE(PG8_SA(1, 0), cA + kstep, voffA); PG8_STAGE(PG8_SB(1, 1), cB + hstep + kstep, voffB);
        PG8_WAIT_V(6); PG8_BAR;
    }
    for (;;) {
        const bool has_next = S.next(ui + 1, nxt);
        const char* nA = has_next ? (const char*)g.A + (size_t)nxt.pm * tstep : cA; const char* nB = has_next ? (const char*)g.Bt + (size_t)nxt.pn * tstep : cB;
        for (int t = 0; t < nt; t += 2) {
            if constexpr (Epi::MID) { if (t == Epi::MID_T0 || t == Epi::MID_T1) { if constexpr (FP8) asm volatile("s_nop 15\n\ts_nop 7" ::: "memory"); E.mid(acc, cur, wr, wc, fr, fq, t); } }
            const bool last = (t == nt - 2);
            const char* a1 = cA + (size_t)(t + 1) * kstep;
            const char* a2 = last ? nA : cA + (size_t)(t + 2) * kstep; const char* b2 = last ? nB : cB + (size_t)(t + 2) * kstep;
            const char* a3 = a2 + kstep; const char* b3 = b2 + kstep;
            if (last && has_next) S.a_ready(nxt);
            if constexpr (SP2) {
            PG8_LDB(B0, 0, 0); PG8_LDB(B1, 0, 1); PG8_SCHED; PG8_LDA(At, 0, 0); PG8_STAGE(PG8_SA(1, 1), a1 + hstep, voffA);
            PG8_WAIT_V(8); PG8_WAIT_L(0); PG8_BAR; PG8_MMA(0, 0, At, B0); PG8_MMA(0, 1, At, B1); PG8_BAR; PG8_SCHED;
            PG8_LDA(At, 0, 1); PG8_STAGE(PG8_SB(0, 0), b2, voffB); PG8_STAGE(PG8_SB(0, 1), b2 + hstep, voffB); PG8_STAGE(PG8_SA(0, 0), a2, voffA);
            PG8_WAIT_V(8); PG8_WAIT_L(0); PG8_BAR; PG8_MMA(1, 0, At, B0); PG8_MMA(1, 1, At, B1); PG8_BAR; PG8_SCHED;
            PG8_LDB(B0, 1, 0); PG8_LDB(B1, 1, 1); PG8_SCHED; PG8_LDA(At, 1, 0); PG8_STAGE(PG8_SA(0, 1), a2 + hstep, voffA);
            PG8_WAIT_V(8); PG8_WAIT_L(0); PG8_BAR; PG8_MMA(0, 0, At, B0); PG8_MMA(0, 1, At, B1); PG8_BAR; PG8_SCHED;
            PG8_LDA(At, 1, 1); PG8_STAGE(PG8_SB(1, 0), b3, voffB); PG8_STAGE(PG8_SB(1, 1), b3 + hstep, voffB); PG8_STAGE(PG8_SA(1, 0), a3, voffA);
            PG8_WAIT_V(8); PG8_WAIT_L(0); PG8_BAR; PG8_MMA(1, 0, At, B0); PG8_MMA(1, 1, At, B1); PG8_BAR; PG8_SCHED;
            } else {
            PG8_LDB(B0, 0, 0); PG8_SCHED; PG8_LDA(At, 0, 0); PG8_STAGE(PG8_SA(1, 1), a1 + hstep, voffA);
            PG8_WAIT_L(8); PG8_BAR; PG8_WAIT_L(0); PG8_MMA(0, 0, At, B0); PG8_BAR; PG8_SCHED;
            PG8_LDB(B1, 0, 1); PG8_STAGE(PG8_SB(0, 0), b2, voffB);
            PG8_BAR; PG8_WAIT_L(0); PG8_MMA(0, 1, At, B1); PG8_BAR;
            PG8_LDA(At, 0, 1); PG8_STAGE(PG8_SA(0, 0), a2, voffA);
            PG8_BAR; PG8_WAIT_L(0); PG8_MMA(1, 0, At, B0); PG8_BAR; PG8_SCHED;
            PG8_STAGE(PG8_SB(0, 1), b2 + hstep, voffB);
            PG8_WAIT_V(6); PG8_BAR; PG8_MMA(1, 1, At, B1); PG8_BAR;
            PG8_LDB(B0, 1, 0); PG8_SCHED; PG8_LDA(At, 1, 0); PG8_STAGE(PG8_SA(0, 1), a2 + hstep, voffA);
            PG8_WAIT_L(8); PG8_BAR; PG8_WAIT_L(0); PG8_MMA(0, 0, At, B0); PG8_BAR; PG8_SCHED;
            PG8_LDB(B1, 1, 1); PG8_STAGE(PG8_SB(1, 0), b3, voffB);
            PG8_BAR; PG8_WAIT_L(0); PG8_MMA(0, 1, At, B1); PG8_BAR;
            PG8_LDA(At, 1, 1); PG8_STAGE(PG8_SA(1, 0), a3, voffA);
            PG8_BAR; PG8_WAIT_L(0); PG8_MMA(1, 0, At, B0); PG8_BAR; PG8_SCHED;
            PG8_STAGE(PG8_SB(1, 1), b3 + hstep, voffB);
            PG8_WAIT_V(6); PG8_BAR; PG8_MMA(1, 1, At, B1); PG8_BAR;
            }
        }
        if constexpr (ALIGN_EPI) { if (wr == 0) PG8_BAR; }
        if constexpr (FP8) asm volatile("s_nop 15\n\ts_nop 7" ::: "memory");
        if constexpr (!Epi::AFTER_DRAIN) { E(acc, cur, wr, wc, fr, fq); S.done(cur); }
        if (!has_next) break;
#pragma unroll
        for (int a = 0; a < 2; ++a)
#pragma unroll
            for (int b = 0; b < 2; ++b)
#pragma unroll
                for (int m = 0; m < 4; ++m)
#pragma unroll
                    for (int n = 0; n < 2; ++n) acc[a][b][m][n] = (f32x4){0.f, 0.f, 0.f, 0.f};
        cur = nxt; cA = nA; cB = nB; ++ui;
        if constexpr (ALIGN_EPI) { if (wr == 1) PG8_BAR; }
    }
    PG8_WAIT_V(0);
    if constexpr (!ALIGN_EPI) { if (wr == 0) PG8_BAR; }
    PG8_BAR;
    if constexpr (Epi::AFTER_DRAIN) { E.fused(acc, cur, wr, wc, fr, fq, lds, wid, lane); S.done(cur); }
#undef PG8_SA
#undef PG8_SB
#undef PG8_STAGE
#undef PG8_LDA
#undef PG8_LDB
#undef PG8_MMA
#undef PG8_WAIT_V
#undef PG8_WAIT_L
#undef PG8_BAR
#undef PG8_SCHED
}
}
using pg8::bf16_t; using pg8::bf16x8; using pg8::f32x4; using pg8::u32x4;
__device__ __forceinline__ int crow(int r, int hi) { return (r & 3) + 8 * (r >> 2) + 4 * hi; }
#define SBAR() __builtin_amdgcn_sched_barrier(0)

namespace att {
constexpr int NW = 8, QBLK = 32, KVBLK = 64, DV = 64;
constexpr int SHM_V = KVBLK * DV * 2, SHM_K = KVBLK * 256;
constexpr int LDS_BYTES = 2 * SHM_V + 2 * SHM_K + NW * 64 * 4;
constexpr float THR = 8.f;
#define KSWZ(row, colB) ((row) * 256 + ((colB) ^ (((row) & 15) << 4)))

template <int DK> struct Scale { static constexpr float v = (DK == 64) ? 0.125f : 0.10206207261596575f; };

constexpr float THR2 = 11.5f;
__device__ __forceinline__ float max3f(float a, float b, float c) { return __builtin_fmaxf(__builtin_fmaxf(a, b), c); }
__device__ __forceinline__ void partialSM(f32x16& p0, f32x16& p1, float& m_reg, f32x16& negm, float& alpha) {
  float a = max3f(p0[0], p0[1], p1[0]), b = max3f(p0[2], p0[3], p1[1]); a = max3f(a, p1[2], p1[3]);
#pragma unroll
  for (int r = 4; r < 16; r += 4) { a = max3f(a, p0[r], p0[r + 1]); b = max3f(b, p0[r + 2], p0[r + 3]); a = max3f(a, p1[r], p1[r + 1]); b = max3f(b, p1[r + 2], p1[r + 3]); }
  float pmax = __builtin_fmaxf(a, b);
  { auto rr = __builtin_amdgcn_permlane32_swap(__float_as_uint(pmax), __float_as_uint(pmax), false, false);
    pmax = __builtin_fmaxf(__uint_as_float(rr[0]), __uint_as_float(rr[1])); }
  if (__builtin_expect(__all(pmax <= THR2), 1)) { alpha = 1.f; }
  else { const float d = __builtin_fmaxf(pmax, 0.f); alpha = __builtin_amdgcn_exp2f(-d); m_reg += d;
#pragma unroll
    for (int r = 0; r < 16; ++r) { p0[r] -= d; p1[r] -= d; }
#pragma unroll
    for (int r = 0; r < 16; ++r) negm[r] = -m_reg;
    asm volatile("" : "+v"(negm)); }
#pragma unroll
  for (int r = 0; r < 16; ++r) p0[r] = __builtin_amdgcn_exp2f(p0[r]);
}
__device__ __forceinline__ void finishSM(f32x16& p0, f32x16& p1, float alpha, float& l_reg, bf16x8& pa0, bf16x8& pa1, bf16x8& pa2, bf16x8& pa3) {
#pragma unroll
  for (int r = 0; r < 16; ++r) p1[r] = __builtin_amdgcn_exp2f(p1[r]);
  float ps = 0;
#pragma unroll
  for (int r = 0; r < 16; ++r) ps += p0[r];
#pragma unroll
  for (int r = 0; r < 16; ++r) ps += p1[r];
  { auto rr = __builtin_amdgcn_permlane32_swap(__float_as_uint(ps), __float_as_uint(ps), false, false);
    ps = __uint_as_float(rr[0]) + __uint_as_float(rr[1]); }
  l_reg = l_reg * alpha + ps;
#define PK4(P, BASE, OUT) do { u32x4 w = {cvtpk(P[BASE + 0], P[BASE + 1]), cvtpk(P[BASE + 2], P[BASE + 3]), cvtpk(P[BASE + 4], P[BASE + 5]), cvtpk(P[BASE + 6], P[BASE + 7])}; OUT = __builtin_bit_cast(bf16x8, w); } while (0)
  PK4(p0, 0, pa0); PK4(p0, 8, pa1); PK4(p1, 0, pa2); PK4(p1, 8, pa3);
#undef PK4
}
template <int DK>
__device__ __forceinline__ void qkt(f32x16& p0, f32x16& p1, const char* Ks, const bf16x8* qr, const f32x16& negm, int r32, int hi) {
#pragma unroll
  for (int d0 = 0; d0 < DK / 16; ++d0) { const int cb = (d0 * 16 + hi * 8) * 2;
    const bf16x8 b0 = *reinterpret_cast<const bf16x8*>(Ks + KSWZ(r32, cb));
    const bf16x8 b1 = *reinterpret_cast<const bf16x8*>(Ks + KSWZ(32 + r32, cb));
    if (d0 == 0) { p0 = __builtin_amdgcn_mfma_f32_32x32x16_bf16(b0, qr[0], negm, 0, 0, 0); p1 = __builtin_amdgcn_mfma_f32_32x32x16_bf16(b1, qr[0], negm, 0, 0, 0); }
    else { p0 = __builtin_amdgcn_mfma_f32_32x32x16_bf16(b0, qr[d0], p0, 0, 0, 0); p1 = __builtin_amdgcn_mfma_f32_32x32x16_bf16(b1, qr[d0], p1, 0, 0, 0); } }
}
__device__ __forceinline__ int v_st(int k, int c) { const int kk = k; return ((kk >> 3) * 2 + (c >> 5)) * 512 + ((kk & 7) * 32 + (c & 31)) * 2; }
__device__ __forceinline__ int v_rd_base(int lane) { return ((lane & 3) << 3) | (((lane >> 2) & 3) << 6) | (((lane >> 4) & 1) << 5) | (((lane >> 5) & 1) << 8); }
constexpr int v_rd_off(int d0, int ks, int half) { return d0 * 512 + ks * 2048 + half * 1024; }
template <int OFF> __device__ __forceinline__ s16x4 tr_read(int vb) {
  s16x4 r; asm volatile("ds_read_b64_tr_b16 %0, %1 offset:%2" : "=&v"(r) : "v"(vb), "i"(OFF) : "memory"); return r;
}
template <int D0> __device__ __forceinline__ void pv_one(f32x16& od, int vb, bf16x8 pa0, bf16x8 pa1, bf16x8 pa2, bf16x8 pa3) {
  const s16x4 l0 = tr_read<v_rd_off(D0, 0, 0)>(vb), h0 = tr_read<v_rd_off(D0, 0, 1)>(vb), l1 = tr_read<v_rd_off(D0, 1, 0)>(vb), h1 = tr_read<v_rd_off(D0, 1, 1)>(vb);
  const s16x4 l2 = tr_read<v_rd_off(D0, 2, 0)>(vb), h2 = tr_read<v_rd_off(D0, 2, 1)>(vb), l3 = tr_read<v_rd_off(D0, 3, 0)>(vb), h3 = tr_read<v_rd_off(D0, 3, 1)>(vb);
  asm volatile("s_waitcnt lgkmcnt(0)" ::: "memory"); SBAR();
#define PK(L, H) (bf16x8){L[0], L[1], L[2], L[3], H[0], H[1], H[2], H[3]}
  od = __builtin_amdgcn_mfma_f32_32x32x16_bf16(PK(l0, h0), pa0, od, 0, 0, 0);
  od = __builtin_amdgcn_mfma_f32_32x32x16_bf16(PK(l1, h1), pa1, od, 0, 0, 0);
  od = __builtin_amdgcn_mfma_f32_32x32x16_bf16(PK(l2, h2), pa2, od, 0, 0, 0);
  od = __builtin_amdgcn_mfma_f32_32x32x16_bf16(PK(l3, h3), pa3, od, 0, 0, 0);
#undef PK
}
__device__ __forceinline__ void pv_d0(f32x16* o, int vb, bf16x8 pa0, bf16x8 pa1, bf16x8 pa2, bf16x8 pa3) {
  pv_one<0>(o[0], vb, pa0, pa1, pa2, pa3); pv_one<1>(o[1], vb, pa0, pa1, pa2, pa3);
}

#define ABAR() asm volatile("s_waitcnt lgkmcnt(0)\n\ts_barrier" ::: "memory")
template <int DK>
__device__ __forceinline__ void attn_unit(const bf16_t* __restrict__ Qb, int ldq, const bf16_t* __restrict__ Kh, int ldk, const bf16_t* __restrict__ Vh, int ldv,
                                          bf16_t* __restrict__ Ob, int ldo, int seq, char* lds) {
  int tid = threadIdx.x; asm volatile("" : "+v"(tid));
  const int wid = tid >> 6, lane = tid & 63, r32 = lane & 31, hi = lane >> 5;
  char* V_lds = lds; char* K_lds = lds + 2 * SHM_V;
  float* ws = (float*)(lds + 2 * SHM_V + 2 * SHM_K) + wid * 64; float* li_l = ws; float* al_l = ws + 32;
  float m_reg = 0.f, l_reg = 0; f32x16 o[2] = {}; bf16x8 qr[DK / 16]; f32x16 negm = {}; asm volatile("" : "+v"(negm));
  const bf16_t* Qw = Qb + (long)(wid * QBLK + r32) * ldq + hi * 8;
#pragma unroll
  for (int d0 = 0; d0 < DK / 16; ++d0) qr[d0] = *reinterpret_cast<const bf16x8*>(Qw + d0 * 16);
  constexpr int CPR = DK / 8;
  const int kc0 = tid, kc1 = 512 + (tid & 255);
  const int kr0 = kc0 / CPR, kcc0 = kc0 % CPR, kr1 = kc1 / CPR, kcc1 = kc1 % CPR;
  const int vr = tid >> 3, vcc = tid & 7;
  const int kst0 = KSWZ(kr0, kcc0 * 16), kst1 = KSWZ(kr1, kcc1 * 16), vst0 = v_st(vr, vcc * 8);
  const int vb0 = (int)(uintptr_t)V_lds + v_rd_base(lane);
  struct { bf16x8 ks0, ks1, vs0; } sr_[2];
#define SLOAD(i, k0) do { sr_[i].ks0 = *reinterpret_cast<const bf16x8*>(&Kh[(long)((k0) + kr0) * ldk + kcc0 * 8]); \
    if (DK == 96) sr_[i].ks1 = *reinterpret_cast<const bf16x8*>(&Kh[(long)((k0) + kr1) * ldk + kcc1 * 8]); \
    sr_[i].vs0 = *reinterpret_cast<const bf16x8*>(&Vh[(long)((k0) + vr) * ldv + vcc * 8]); } while (0)
#define SWRITE(b, i) do { *(bf16x8*)(K_lds + (b) * SHM_K + kst0) = sr_[i].ks0; if (DK == 96) *(bf16x8*)(K_lds + (b) * SHM_K + kst1) = sr_[i].ks1; \
    *(bf16x8*)(V_lds + (b) * SHM_V + vst0) = sr_[i].vs0; } while (0)
#define SWAIT() do { if (DK == 96) asm volatile("s_waitcnt vmcnt(3)" ::: "memory"); else asm volatile("s_waitcnt vmcnt(2)" ::: "memory"); } while (0)
#define RESC(a) do { if (__any((a) < 1.f)) { _Pragma("unroll") for (int d = 0; d < 2; ++d) _Pragma("unroll") for (int r = 0; r < 16; ++r) o[d][r] *= (a); } } while (0)
  f32x16 pA0, pA1, pB0, pB1; float alA, alB; bf16x8 pa0, pa1, pa2, pa3; const int NT = seq / KVBLK;
  constexpr int SE = 0, SO = 1;
  SLOAD(SE, 0); asm volatile("s_waitcnt vmcnt(0)" ::: "memory"); SWRITE(0, SE); ABAR();
  qkt<DK>(pA0, pA1, K_lds, qr, negm, r32, hi); partialSM(pA0, pA1, m_reg, negm, alA);
  SLOAD(SO, KVBLK); if (2 < NT) SLOAD(SE, 2 * KVBLK);
  SWAIT(); SWRITE(1, SO); ABAR();
  for (int j = 1; j + 1 < NT; j += 2) {
    SBAR(); qkt<DK>(pB0, pB1, K_lds + SHM_K, qr, negm, r32, hi);
    finishSM(pA0, pA1, alA, l_reg, pa0, pa1, pa2, pa3); SBAR();
    SLOAD(SO, (j + 2) * KVBLK); SBAR();
    pv_d0(o, vb0, pa0, pa1, pa2, pa3); partialSM(pB0, pB1, m_reg, negm, alB);
    ABAR(); SWAIT(); SWRITE(0, SE);
    RESC(alB); ABAR();
    SBAR(); qkt<DK>(pA0, pA1, K_lds, qr, negm, r32, hi);
    finishSM(pB0, pB1, alB, l_reg, pa0, pa1, pa2, pa3); SBAR();
    if (j + 3 < NT) SLOAD(SE, (j + 3) * KVBLK); SBAR();
    pv_d0(o, vb0 + SHM_V, pa0, pa1, pa2, pa3); partialSM(pA0, pA1, m_reg, negm, alA);
    ABAR(); SWAIT(); SWRITE(1, SO);
    RESC(alA); ABAR();
  }
  SBAR(); qkt<DK>(pB0, pB1, K_lds + SHM_K, qr, negm, r32, hi);
  finishSM(pA0, pA1, alA, l_reg, pa0, pa1, pa2, pa3); SBAR();
  pv_d0(o, vb0, pa0, pa1, pa2, pa3); partialSM(pB0, pB1, m_reg, negm, alB);
  ABAR(); RESC(alB);
  finishSM(pB0, pB1, alB, l_reg, pa0, pa1, pa2, pa3); SBAR();
  pv_d0(o, vb0 + SHM_V, pa0, pa1, pa2, pa3);
  const float rl = __builtin_amdgcn_rcpf(l_reg);
  bf16_t* Ow = Ob + (long)(wid * QBLK + r32) * ldo + 4 * hi;
#pragma unroll
  for (int d0 = 0; d0 < 2; ++d0)
#pragma unroll
    for (int g = 0; g < 4; ++g) { u32x2 w; w.x = cvtpk(o[d0][4 * g] * rl, o[d0][4 * g + 1] * rl); w.y = cvtpk(o[d0][4 * g + 2] * rl, o[d0][4 * g + 3] * rl);
      *(u32x2*)(Ow + d0 * 32 + 8 * g) = w; }
  ABAR();
#undef SLOAD
#undef SWRITE
#undef SWAIT
#undef RESC
}
constexpr int NBUF = 3;
constexpr int LDS_BYTES2 = NBUF * SHM_V + NBUF * SHM_K + NW * 64 * 4;
template <int DK>
__device__ __forceinline__ void attn_unit2(const bf16_t* __restrict__ Qb, int ldq, const bf16_t* __restrict__ Kh, int ldk, const bf16_t* __restrict__ Vh, int ldv,
                                           bf16_t* __restrict__ Ob, int ldo, int seq, char* lds) {
  int tid = threadIdx.x; asm volatile("" : "+v"(tid));
  const int wid = __builtin_amdgcn_readfirstlane(tid >> 6), lane = tid & 63, r32 = lane & 31, hi = lane >> 5;
  const bool halfB = wid >= 4;
  char* V_lds = lds; char* K_lds = lds + NBUF * SHM_V;
  float* ws = (float*)(lds + NBUF * SHM_V + NBUF * SHM_K) + wid * 64; float* li_l = ws; float* al_l = ws + 32;
  float m_reg = 0.f, l_reg = 0; f32x16 o[2] = {}; bf16x8 qr[DK / 16]; f32x16 negm = {}; asm volatile("" : "+v"(negm));
  const bf16_t* Qw = Qb + (long)(wid * QBLK + r32) * ldq + hi * 8;
#pragma unroll
  for (int d0 = 0; d0 < DK / 16; ++d0) qr[d0] = *reinterpret_cast<const bf16x8*>(Qw + d0 * 16);
  constexpr int CPR = DK / 8;
  const int kc0 = tid, kc1 = 512 + (tid & 255);
  const int kr0 = kc0 / CPR, kcc0 = kc0 % CPR, kr1 = kc1 / CPR, kcc1 = kc1 % CPR;
  const int vr = tid >> 3, vcc = tid & 7;
  const int kst0 = KSWZ(kr0, kcc0 * 16), kst1 = KSWZ(kr1, kcc1 * 16), vst0 = v_st(vr, vcc * 8);
  const int vb0 = (int)(uintptr_t)V_lds + v_rd_base(lane);
  bf16x8 ks0, ks1, vs0;
#define SLOAD(k0) do { ks0 = *reinterpret_cast<const bf16x8*>(&Kh[(long)((k0) + kr0) * ldk + kcc0 * 8]); \
    if (DK == 96) ks1 = *reinterpret_cast<const bf16x8*>(&Kh[(long)((k0) + kr1) * ldk + kcc1 * 8]); \
    vs0 = *reinterpret_cast<const bf16x8*>(&Vh[(long)((k0) + vr) * ldv + vcc * 8]); } while (0)
#define SWRITE(b) do { *(bf16x8*)(K_lds + (b) * SHM_K + kst0) = ks0; if (DK == 96) *(bf16x8*)(K_lds + (b) * SHM_K + kst1) = ks1; \
    *(bf16x8*)(V_lds + (b) * SHM_V + vst0) = vs0; } while (0)
#define RESC(a) do { if (__any((a) < 1.f)) { _Pragma("unroll") for (int d = 0; d < 2; ++d) _Pragma("unroll") for (int r = 0; r < 16; ++r) o[d][r] *= (a); } } while (0)
  f32x16 pA0, pA1, pB0, pB1; float alA, alB; bf16x8 pa0, pa1, pa2, pa3; const int NT = seq / KVBLK;
  SLOAD(0); SWRITE(0); SLOAD(KVBLK); SWRITE(1); if (2 < NT) SLOAD(2 * KVBLK);
  ABAR();
  qkt<DK>(pA0, pA1, K_lds, qr, negm, r32, hi); partialSM(pA0, pA1, m_reg, negm, alA);
  if (halfB) ABAR();
  int vprev = 0, kb = 1, wbuf = 2;
#define ROT3() do { const int t_ = vprev; vprev = kb; kb = wbuf; wbuf = t_; } while (0)
  for (int j = 1; j + 1 < NT; j += 2) {
    SBAR(); qkt<DK>(pB0, pB1, K_lds + kb * SHM_K, qr, negm, r32, hi); ABAR();
    finishSM(pA0, pA1, alA, l_reg, pa0, pa1, pa2, pa3); SBAR(); SWRITE(wbuf); SLOAD((j + 2) * KVBLK); ABAR();
    pv_d0(o, vb0 + vprev * SHM_V, pa0, pa1, pa2, pa3); ABAR();
    partialSM(pB0, pB1, m_reg, negm, alB); RESC(alB); ABAR();
    ROT3();
    SBAR(); qkt<DK>(pA0, pA1, K_lds + kb * SHM_K, qr, negm, r32, hi); ABAR();
    finishSM(pB0, pB1, alB, l_reg, pa0, pa1, pa2, pa3); SBAR(); SWRITE(wbuf); if (j + 3 < NT) SLOAD((j + 3) * KVBLK); ABAR();
    pv_d0(o, vb0 + vprev * SHM_V, pa0, pa1, pa2, pa3); ABAR();
    partialSM(pA0, pA1, m_reg, negm, alA); RESC(alA); ABAR();
    ROT3();
  }
  SBAR(); qkt<DK>(pB0, pB1, K_lds + kb * SHM_K, qr, negm, r32, hi); ABAR();
  finishSM(pA0, pA1, alA, l_reg, pa0, pa1, pa2, pa3); ABAR();
  pv_d0(o, vb0 + vprev * SHM_V, pa0, pa1, pa2, pa3); ABAR();
  partialSM(pB0, pB1, m_reg, negm, alB); RESC(alB); ABAR();
  if (!halfB) ABAR();
  finishSM(pB0, pB1, alB, l_reg, pa0, pa1, pa2, pa3); SBAR();
  pv_d0(o, vb0 + kb * SHM_V, pa0, pa1, pa2, pa3);
  const float rl = __builtin_amdgcn_rcpf(l_reg);
  bf16_t* Ow = Ob + (long)(wid * QBLK + r32) * ldo + 4 * hi;
#pragma unroll
  for (int d0 = 0; d0 < 2; ++d0)
#pragma unroll
    for (int g = 0; g < 4; ++g) { u32x2 w; w.x = cvtpk(o[d0][4 * g] * rl, o[d0][4 * g + 1] * rl); w.y = cvtpk(o[d0][4 * g + 2] * rl, o[d0][4 * g + 3] * rl);
      *(u32x2*)(Ow + d0 * 32 + 8 * g) = w; }
  ABAR();
#undef SLOAD
#undef SWRITE
#undef RESC
#undef ROT3
}
constexpr int NBUF4 = 4;
constexpr int LDS_BYTES3 = NBUF4 * SHM_V + NBUF4 * SHM_K + NW * 64 * 4;
template <int DK>
__device__ __forceinline__ void attn_unit3(const bf16_t* __restrict__ Qb, int ldq, const bf16_t* __restrict__ Kh, int ldk, const bf16_t* __restrict__ Vh, int ldv,
                                           bf16_t* __restrict__ Ob, int ldo, int seq, char* lds) {
  int tid = threadIdx.x; asm volatile("" : "+v"(tid));
  const int wid = tid >> 6, lane = tid & 63, r32 = lane & 31, hi = lane >> 5;
  char* V_lds = lds; char* K_lds = lds + NBUF4 * SHM_V;
  float m_reg = 0.f, l_reg = 0; f32x16 o[2] = {}; bf16x8 qr[DK / 16]; f32x16 negm = {}; asm volatile("" : "+v"(negm));
  const bf16_t* Qw = Qb + (long)(wid * QBLK + r32) * ldq + hi * 8;
#pragma unroll
  for (int d0 = 0; d0 < DK / 16; ++d0) qr[d0] = *reinterpret_cast<const bf16x8*>(Qw + d0 * 16);
  constexpr int CPR = DK / 8;
  const int kc0 = tid, kc1 = 512 + (tid & 255);
  const int kr0 = kc0 / CPR, kcc0 = kc0 % CPR, kr1 = kc1 / CPR, kcc1 = kc1 % CPR;
  const int vr = tid >> 3, vcc = tid & 7;
  const int kst0 = KSWZ(kr0, kcc0 * 16), kst1 = KSWZ(kr1, kcc1 * 16), vst0 = v_st(vr, vcc * 8);
  const int vb0 = (int)(uintptr_t)V_lds + v_rd_base(lane);
  bf16x8 ks0, ks1, vs0;
#define SLOAD(k0) do { ks0 = *reinterpret_cast<const bf16x8*>(&Kh[(long)((k0) + kr0) * ldk + kcc0 * 8]); \
    if (DK == 96) ks1 = *reinterpret_cast<const bf16x8*>(&Kh[(long)((k0) + kr1) * ldk + kcc1 * 8]); \
    vs0 = *reinterpret_cast<const bf16x8*>(&Vh[(long)((k0) + vr) * ldv + vcc * 8]); } while (0)
#define SWRITE(b) do { *(bf16x8*)(K_lds + (b) * SHM_K + kst0) = ks0; if (DK == 96) *(bf16x8*)(K_lds + (b) * SHM_K + kst1) = ks1; \
    *(bf16x8*)(V_lds + (b) * SHM_V + vst0) = vs0; } while (0)
#define RESC(a) do { if (__any((a) < 1.f)) { _Pragma("unroll") for (int d = 0; d < 2; ++d) _Pragma("unroll") for (int r = 0; r < 16; ++r) o[d][r] *= (a); } } while (0)
  f32x16 pA0, pA1, pB0, pB1; float alA, alB; bf16x8 pa0, pa1, pa2, pa3; const int NT = seq / KVBLK;
  SLOAD(0); SWRITE(0); SLOAD(KVBLK); SWRITE(1); SLOAD(2 * KVBLK); SWRITE(2); if (3 < NT) SLOAD(3 * KVBLK);
  ABAR();
  qkt<DK>(pA0, pA1, K_lds, qr, negm, r32, hi); partialSM(pA0, pA1, m_reg, negm, alA);
  int vprev = 0, kb = 1, wb = 3;
  for (int j = 1; j + 1 < NT; j += 2) {
    SBAR(); qkt<DK>(pB0, pB1, K_lds + kb * SHM_K, qr, negm, r32, hi);
    finishSM(pA0, pA1, alA, l_reg, pa0, pa1, pa2, pa3); SBAR();
    pv_d0(o, vb0 + vprev * SHM_V, pa0, pa1, pa2, pa3); partialSM(pB0, pB1, m_reg, negm, alB);
    ABAR();
    SWRITE(wb); if (j + 3 < NT) SLOAD((j + 3) * KVBLK);
    RESC(alB);
    vprev = kb; kb = (kb + 1) & 3; wb = (wb + 1) & 3;
    SBAR(); qkt<DK>(pA0, pA1, K_lds + kb * SHM_K, qr, negm, r32, hi);
    finishSM(pB0, pB1, alB, l_reg, pa0, pa1, pa2, pa3); SBAR();
    pv_d0(o, vb0 + vprev * SHM_V, pa0, pa1, pa2, pa3); partialSM(pA0, pA1, m_reg, negm, alA);
    ABAR();
    if (j + 3 < NT) SWRITE(wb); if (j + 4 < NT) SLOAD((j + 4) * KVBLK);
    RESC(alA);
    vprev = kb; kb = (kb + 1) & 3; wb = (wb + 1) & 3;
  }
  SBAR(); qkt<DK>(pB0, pB1, K_lds + kb * SHM_K, qr, negm, r32, hi);
  finishSM(pA0, pA1, alA, l_reg, pa0, pa1, pa2, pa3); SBAR();
  pv_d0(o, vb0 + vprev * SHM_V, pa0, pa1, pa2, pa3); partialSM(pB0, pB1, m_reg, negm, alB);
  RESC(alB);
  finishSM(pB0, pB1, alB, l_reg, pa0, pa1, pa2, pa3); SBAR();
  pv_d0(o, vb0 + kb * SHM_V, pa0, pa1, pa2, pa3);
  const float rl = __builtin_amdgcn_rcpf(l_reg);
  bf16_t* Ow = Ob + (long)(wid * QBLK + r32) * ldo + 4 * hi;
#pragma unroll
  for (int d0 = 0; d0 < 2; ++d0)
#pragma unroll
    for (int g = 0; g < 4; ++g) { u32x2 w; w.x = cvtpk(o[d0][4 * g] * rl, o[d0][4 * g + 1] * rl); w.y = cvtpk(o[d0][4 * g + 2] * rl, o[d0][4 * g + 3] * rl);
      *(u32x2*)(Ow + d0 * 32 + 8 * g) = w; }
  ABAR();
#undef SLOAD
#undef SWRITE
#undef RESC
}
typedef short v4i16_t __attribute__((ext_vector_type(4)));
__device__ __forceinline__ s16x4 vtr(int addr) { return __builtin_bit_cast(s16x4, __builtin_amdgcn_ds_read_tr16_b64_v4i16((__attribute__((address_space(3))) v4i16_t*)(uintptr_t)(unsigned)addr)); }
#define SGB(mask, n) __builtin_amdgcn_sched_group_barrier((mask), (n), 0)
template <int DK>
__device__ __forceinline__ void attn_unit4(const bf16_t* __restrict__ Qb, int ldq, const bf16_t* __restrict__ Kh, int ldk, const bf16_t* __restrict__ Vh, int ldv,
                                           bf16_t* __restrict__ Ob, int ldo, int seq, char* lds) {
  int tid = threadIdx.x; asm volatile("" : "+v"(tid));
  const int wid = tid >> 6, lane = tid & 63, r32 = lane & 31, hi = lane >> 5;
  char* V_lds = lds; char* K_lds = lds + 2 * SHM_V;
  float m_reg = 0.f; f32x16 o[2] = {}; bf16x8 qr[DK / 16]; f32x16 negm = {}; asm volatile("" : "+v"(negm));
  f32x16 lacc = {};
  const bf16x8 ones = __builtin_bit_cast(bf16x8, (u32x4){0x3F803F80u, 0x3F803F80u, 0x3F803F80u, 0x3F803F80u});
  const bf16_t* Qw = Qb + (long)(wid * QBLK + r32) * ldq + hi * 8;
#pragma unroll
  for (int d0 = 0; d0 < DK / 16; ++d0) qr[d0] = *reinterpret_cast<const bf16x8*>(Qw + d0 * 16);
  constexpr int CPR = DK / 8, NKF = DK / 8;
  const int kc0 = tid, kc1 = 512 + (tid & 255);
  const int kr0 = kc0 / CPR, kcc0 = kc0 % CPR, kr1 = kc1 / CPR, kcc1 = kc1 % CPR;
  const int vr = tid >> 3, vcc = tid & 7;
  const int kst0 = KSWZ(kr0, kcc0 * 16), kst1 = KSWZ(kr1, kcc1 * 16), vst0 = v_st(vr, vcc * 8);
  const int vb0 = (int)(uintptr_t)V_lds + v_rd_base(lane);
  struct { bf16x8 ks0, ks1, vs0; } sr_[1];
#define SLOAD(i, k0) do { sr_[i].ks0 = *reinterpret_cast<const bf16x8*>(&Kh[(long)((k0) + kr0) * ldk + kcc0 * 8]); \
    if (DK == 96) sr_[i].ks1 = *reinterpret_cast<const bf16x8*>(&Kh[(long)((k0) + kr1) * ldk + kcc1 * 8]); \
    sr_[i].vs0 = *reinterpret_cast<const bf16x8*>(&Vh[(long)((k0) + vr) * ldv + vcc * 8]); } while (0)
#define SWRITE(b, i) do { *(bf16x8*)(K_lds + (b) * SHM_K + kst0) = sr_[i].ks0; if (DK == 96) *(bf16x8*)(K_lds + (b) * SHM_K + kst1) = sr_[i].ks1; \
    *(bf16x8*)(V_lds + (b) * SHM_V + vst0) = sr_[i].vs0; } while (0)
#define SWAIT() do { if (DK == 96) asm volatile("s_waitcnt vmcnt(3)" ::: "memory"); else asm volatile("s_waitcnt vmcnt(2)" ::: "memory"); } while (0)
#define RESC(a) do { if (__any((a) < 1.f)) { _Pragma("unroll") for (int d = 0; d < 2; ++d) _Pragma("unroll") for (int r = 0; r < 16; ++r) o[d][r] *= (a); _Pragma("unroll") for (int r = 0; r < 16; ++r) lacc[r] *= (a); } } while (0)
  bf16x8 kf[NKF]; s16x4 vf[16];
#define KLOAD(Ks) do { _Pragma("unroll") for (int d0 = 0; d0 < DK / 16; ++d0) { const int cb = (d0 * 16 + hi * 8) * 2; \
    kf[2 * d0] = *reinterpret_cast<const bf16x8*>((Ks) + KSWZ(r32, cb)); kf[2 * d0 + 1] = *reinterpret_cast<const bf16x8*>((Ks) + KSWZ(32 + r32, cb)); } } while (0)
#define QK_MFMA(P0, P1) do { P0 = __builtin_amdgcn_mfma_f32_32x32x16_bf16(kf[0], qr[0], negm, 0, 0, 0); P1 = __builtin_amdgcn_mfma_f32_32x32x16_bf16(kf[1], qr[0], negm, 0, 0, 0); \
    _Pragma("unroll") for (int d0 = 1; d0 < DK / 16; ++d0) { P0 = __builtin_amdgcn_mfma_f32_32x32x16_bf16(kf[2 * d0], qr[d0], P0, 0, 0, 0); P1 = __builtin_amdgcn_mfma_f32_32x32x16_bf16(kf[2 * d0 + 1], qr[d0], P1, 0, 0, 0); } } while (0)
#define PKP(P, BASE, OUT) do { u32x4 w_ = {cvtpk(P[BASE + 0], P[BASE + 1]), cvtpk(P[BASE + 2], P[BASE + 3]), cvtpk(P[BASE + 4], P[BASE + 5]), cvtpk(P[BASE + 6], P[BASE + 7])}; OUT = __builtin_bit_cast(bf16x8, w_); } while (0)
#define EXPCVT(P0, P1) do { _Pragma("unroll") for (int r = 0; r < 16; ++r) { P0[r] = __builtin_amdgcn_exp2f(P0[r]); P1[r] = __builtin_amdgcn_exp2f(P1[r]); } \
    PKP(P0, 0, pa0); PKP(P0, 8, pa1); PKP(P1, 0, pa2); PKP(P1, 8, pa3); } while (0)
#define VLOAD(vb) do { _Pragma("unroll") for (int d0 = 0; d0 < 2; ++d0) _Pragma("unroll") for (int ks = 0; ks < 4; ++ks) { \
    vf[d0 * 8 + ks * 2] = vtr((vb) + v_rd_off(d0, ks, 0)); vf[d0 * 8 + ks * 2 + 1] = vtr((vb) + v_rd_off(d0, ks, 1)); } } while (0)
#define VFR(i) (bf16x8){vf[2 * (i)][0], vf[2 * (i)][1], vf[2 * (i)][2], vf[2 * (i)][3], vf[2 * (i) + 1][0], vf[2 * (i) + 1][1], vf[2 * (i) + 1][2], vf[2 * (i) + 1][3]}
#define PV_MFMA() do { _Pragma("unroll") for (int d0 = 0; d0 < 2; ++d0) { \
    o[d0] = __builtin_amdgcn_mfma_f32_32x32x16_bf16(VFR(d0 * 4 + 0), pa0, o[d0], 0, 0, 0); o[d0] = __builtin_amdgcn_mfma_f32_32x32x16_bf16(VFR(d0 * 4 + 1), pa1, o[d0], 0, 0, 0); \
    o[d0] = __builtin_amdgcn_mfma_f32_32x32x16_bf16(VFR(d0 * 4 + 2), pa2, o[d0], 0, 0, 0); o[d0] = __builtin_amdgcn_mfma_f32_32x32x16_bf16(VFR(d0 * 4 + 3), pa3, o[d0], 0, 0, 0); } \
    lacc = __builtin_amdgcn_mfma_f32_32x32x16_bf16(ones, pa0, lacc, 0, 0, 0); lacc = __builtin_amdgcn_mfma_f32_32x32x16_bf16(ones, pa1, lacc, 0, 0, 0); \
    lacc = __builtin_amdgcn_mfma_f32_32x32x16_bf16(ones, pa2, lacc, 0, 0, 0); lacc = __builtin_amdgcn_mfma_f32_32x32x16_bf16(ones, pa3, lacc, 0, 0, 0); } while (0)
#define ROWSUM(P0, P1, AL) do { float ps_ = 0.f; _Pragma("unroll") for (int r = 0; r < 16; ++r) ps_ += P0[r]; _Pragma("unroll") for (int r = 0; r < 16; ++r) ps_ += P1[r]; \
    auto rr_ = __builtin_amdgcn_permlane32_swap(__float_as_uint(ps_), __float_as_uint(ps_), false, false); ps_ = __uint_as_float(rr_[0]) + __uint_as_float(rr_[1]); l_reg = l_reg * (AL) + ps_; } while (0)
#define ROWMAX(P0, P1, PM) do { float a_ = max3f(P0[0], P0[1], P1[0]), b_ = max3f(P0[2], P0[3], P1[1]); a_ = max3f(a_, P1[2], P1[3]); \
    _Pragma("unroll") for (int r = 4; r < 16; r += 4) { a_ = max3f(a_, P0[r], P0[r + 1]); b_ = max3f(b_, P0[r + 2], P0[r + 3]); a_ = max3f(a_, P1[r], P1[r + 1]); b_ = max3f(b_, P1[r + 2], P1[r + 3]); } \
    PM = __builtin_fmaxf(a_, b_); auto rr_ = __builtin_amdgcn_permlane32_swap(__float_as_uint(PM), __float_as_uint(PM), false, false); PM = __builtin_fmaxf(__uint_as_float(rr_[0]), __uint_as_float(rr_[1])); } while (0)
#define DECIDE(P0, P1, PM, AL) do { if (__builtin_expect(__all((PM) <= THR2), 1)) { AL = 1.f; } else { const float d_ = __builtin_fmaxf((PM), 0.f); AL = __builtin_amdgcn_exp2f(-d_); m_reg += d_; \
    _Pragma("unroll") for (int r = 0; r < 16; ++r) { P0[r] -= d_; P1[r] -= d_; } _Pragma("unroll") for (int r = 0; r < 16; ++r) negm[r] = -m_reg; asm volatile("" : "+v"(negm)); } } while (0)
#define REGION_A(CUR0, CUR1, PRV0, PRV1, Ks) do { SBAR(); KLOAD(Ks); QK_MFMA(CUR0, CUR1); EXPCVT(PRV0, PRV1); \
    SGB(0x100, NKF); _Pragma("unroll") for (int i_ = 0; i_ < NKF; ++i_) { SGB(0x008, 1); SGB(0x002, (DK == 64 ? 6 : 4)); } SBAR(); } while (0)
#define REGION_B(CUR0, CUR1, PRV0, PRV1, ALP, PM, vb) do { SBAR(); VLOAD(vb); PV_MFMA(); ROWMAX(CUR0, CUR1, PM); \
    SGB(0x100, 16); _Pragma("unroll") for (int i_ = 0; i_ < 12; ++i_) { SGB(0x008, 1); SGB(0x002, 2); } SBAR(); } while (0)
  f32x16 pA0, pA1, pB0, pB1; float alA, alB, pm; bf16x8 pa0, pa1, pa2, pa3; const int NT = seq / KVBLK;
  SLOAD(0, 0); SWRITE(0, 0); SLOAD(0, KVBLK); ABAR();
  KLOAD(K_lds); QK_MFMA(pA0, pA1); ROWMAX(pA0, pA1, pm); DECIDE(pA0, pA1, pm, alA);
  SWRITE(1, 0); SLOAD(0, 2 * KVBLK); ABAR();
  for (int j = 1; j + 1 < NT; j += 2) {
    REGION_A(pB0, pB1, pA0, pA1, K_lds + SHM_K);
    REGION_B(pB0, pB1, pA0, pA1, alA, pm, vb0);
    DECIDE(pB0, pB1, pm, alB);
    ABAR(); SWRITE(0, 0); SLOAD(0, (j + 2) * KVBLK);
    RESC(alB); ABAR();
    REGION_A(pA0, pA1, pB0, pB1, K_lds);
    REGION_B(pA0, pA1, pB0, pB1, alB, pm, vb0 + SHM_V);
    DECIDE(pA0, pA1, pm, alA);
    ABAR(); SWRITE(1, 0); SLOAD(0, ((j + 3 < NT) ? (j + 3) : (NT - 1)) * KVBLK);
    RESC(alA); ABAR();
  }
  REGION_A(pB0, pB1, pA0, pA1, K_lds + SHM_K);
  REGION_B(pB0, pB1, pA0, pA1, alA, pm, vb0);
  DECIDE(pB0, pB1, pm, alB);
  RESC(alB);
  EXPCVT(pB0, pB1); VLOAD(vb0 + SHM_V); PV_MFMA();
  const float rl = __builtin_amdgcn_rcpf(lacc[0]);
  bf16_t* Ow = Ob + (long)(wid * QBLK + r32) * ldo + 4 * hi;
#pragma unroll
  for (int d0 = 0; d0 < 2; ++d0)
#pragma unroll
    for (int g = 0; g < 4; ++g) { u32x2 w; w.x = cvtpk(o[d0][4 * g] * rl, o[d0][4 * g + 1] * rl); w.y = cvtpk(o[d0][4 * g + 2] * rl, o[d0][4 * g + 3] * rl);
      *(u32x2*)(Ow + d0 * 32 + 8 * g) = w; }
  ABAR();
#undef SLOAD
#undef SWRITE
#undef SWAIT
#undef RESC
#undef KLOAD
#undef QK_MFMA
#undef PKP
#undef EXPCVT
#undef VLOAD
#undef VFR
#undef PV_MFMA
#undef ROWSUM
#undef ROWMAX
#undef DECIDE
#undef REGION_A
#undef REGION_B
}
#undef SGB
#undef ABAR
}
#include <hip/hip_bf16.h>
namespace att64 {
using bf16=__hip_bfloat16;
using bf16x8=__attribute__((ext_vector_type(8)))short;
using s16x4=__attribute__((ext_vector_type(4)))short;
using f32x16=__attribute__((ext_vector_type(16)))float;
using u32x4=__attribute__((ext_vector_type(4)))unsigned;
constexpr int SEQ=8192,D=64,NW=8,QBLK=32,QB=QBLK*NW,KVBLK=64;
__device__ __forceinline__ int crow(int r,int hi){return (r&3)+8*(r>>2)+4*hi;}
constexpr int NSLOT=3, SLOTB=8192;
constexpr int LDS_K=0, LDS_V=NSLOT*SLOTB, LDS_WS=2*NSLOT*SLOTB, LDS_OST=LDS_WS+NW*64*4, LDS_BYTES=LDS_OST+NW*4096;
constexpr float C2=0.125f*1.4426950408889634f;
__device__ __forceinline__ void glds16(const void*gsrc,unsigned lds_dst){unsigned keep;
  asm volatile("s_mov_b32 %0, m0\n\ts_mov_b32 m0, %2\n\ts_nop 0\n\tglobal_load_lds_dwordx4 %1, off\n\ts_mov_b32 m0, %0":"=&s"(keep):"v"(gsrc),"s"(lds_dst):"memory");}
__device__ __forceinline__ float max3f(float a,float b,float c){float r;asm("v_max3_f32 %0, %1, %2, %3":"=v"(r):"v"(a),"v"(b),"v"(c));return r;}
__device__ __forceinline__ float max2f(float a,float b){float r;asm("v_max_f32_e32 %0, %1, %2":"=v"(r):"v"(a),"v"(b));return r;}
__device__ __forceinline__ float fadd_s(float a,float b){float r;asm("v_add_f32_e32 %0, %1, %2":"=v"(r):"v"(a),"v"(b));return r;}
__device__ __forceinline__ float fsub_s(float a,float b){float r;asm("v_sub_f32_e32 %0, %1, %2":"=v"(r):"v"(a),"v"(b));return r;}
typedef float f32x2_t __attribute__((ext_vector_type(2))); typedef __bf16 bf16x2_t __attribute__((ext_vector_type(2)));
__device__ __forceinline__ unsigned cvtpk_s(float lo,float hi){f32x2_t v={lo,hi};bf16x2_t b=__builtin_convertvector(v,bf16x2_t);return __builtin_bit_cast(unsigned,b);}
#define WAIT_BAR(N) asm volatile("s_waitcnt vmcnt(" #N ") lgkmcnt(0)\n\ts_barrier":::"memory")

__device__ __forceinline__ void qkt(f32x16&p0,f32x16&p1,const char*Kslot,const bf16x8*qr,const f32x16&negm,int r32,int hi){
  const char*kb=Kslot+hi*1024+r32*16;
  #pragma unroll
  for(int d0=0;d0<4;++d0){
    const bf16x8 b0=*reinterpret_cast<const bf16x8*>(kb+d0*2048);
    const bf16x8 b1=*reinterpret_cast<const bf16x8*>(kb+d0*2048+512);
    if(d0==0){p0=__builtin_amdgcn_mfma_f32_32x32x16_bf16(b0,qr[0],negm,0,0,0);p1=__builtin_amdgcn_mfma_f32_32x32x16_bf16(b1,qr[0],negm,0,0,0);}
    else{p0=__builtin_amdgcn_mfma_f32_32x32x16_bf16(b0,qr[d0],p0,0,0,0);p1=__builtin_amdgcn_mfma_f32_32x32x16_bf16(b1,qr[d0],p1,0,0,0);}}
}
typedef __attribute__((address_space(3))) const char* lds_cptr;
typedef short v4i16_t __attribute__((ext_vector_type(4)));
__device__ __forceinline__ void kload8(bf16x8*kf,lds_cptr kp){
  kf[0]=*(const __attribute__((address_space(3))) bf16x8*)(kp);      kf[1]=*(const __attribute__((address_space(3))) bf16x8*)(kp+512);
  kf[2]=*(const __attribute__((address_space(3))) bf16x8*)(kp+2048); kf[3]=*(const __attribute__((address_space(3))) bf16x8*)(kp+2560);
  kf[4]=*(const __attribute__((address_space(3))) bf16x8*)(kp+4096); kf[5]=*(const __attribute__((address_space(3))) bf16x8*)(kp+4608);
  kf[6]=*(const __attribute__((address_space(3))) bf16x8*)(kp+6144); kf[7]=*(const __attribute__((address_space(3))) bf16x8*)(kp+6656);
}
__device__ __forceinline__ void kload2(bf16x8*kf,lds_cptr kp,int j){ kf[2*j]=*(const __attribute__((address_space(3))) bf16x8*)(kp+j*2048); kf[2*j+1]=*(const __attribute__((address_space(3))) bf16x8*)(kp+j*2048+512); }
__device__ __forceinline__ s16x4 vtr(lds_cptr p){ return __builtin_bit_cast(s16x4,__builtin_amdgcn_ds_read_tr16_b64_v4i16((__attribute__((address_space(3))) v4i16_t*)p)); }
__device__ __forceinline__ float rowmax(const f32x16&p0,const f32x16&p1){
  float a=max3f(p0[0],p0[1],p1[0]),b=max3f(p0[2],p0[3],p1[1]);a=max3f(a,p1[2],p1[3]);
  #pragma unroll
  for(int r=4;r<16;r+=4){a=max3f(a,p0[r],p0[r+1]);b=max3f(b,p0[r+2],p0[r+3]);a=max3f(a,p1[r],p1[r+1]);b=max3f(b,p1[r+2],p1[r+3]);}
  const float m=max2f(a,b);
  auto rr=__builtin_amdgcn_permlane32_swap(__float_as_uint(m),__float_as_uint(m),false,false);
  return max2f(__uint_as_float(rr[0]),__uint_as_float(rr[1]));
}
__device__ __forceinline__ void pv(f32x16*o,int vb,bf16x8 pa0,bf16x8 pa1,bf16x8 pa2,bf16x8 pa3){
  #pragma unroll
  for(int d0=0;d0<2;++d0){s16x4 lo[4],hi[4];
    #pragma unroll
    for(int ks=0;ks<4;++ks){
      asm volatile("ds_read_b64_tr_b16 %0,%1 offset:%c2":"=&v"(lo[ks]):"v"(vb),"i"(d0*4096+ks*1024):"memory");
      asm volatile("ds_read_b64_tr_b16 %0,%1 offset:%c2":"=&v"(hi[ks]):"v"(vb),"i"(d0*4096+ks*1024+512):"memory");}
    asm volatile("s_waitcnt lgkmcnt(0)":::"memory");SBAR();
    #define PK(k) (bf16x8){lo[k][0],lo[k][1],lo[k][2],lo[k][3],hi[k][0],hi[k][1],hi[k][2],hi[k][3]}
    o[d0]=__builtin_amdgcn_mfma_f32_32x32x16_bf16(pa0,PK(0),o[d0],0,0,0);
    o[d0]=__builtin_amdgcn_mfma_f32_32x32x16_bf16(pa1,PK(1),o[d0],0,0,0);
    o[d0]=__builtin_amdgcn_mfma_f32_32x32x16_bf16(pa2,PK(2),o[d0],0,0,0);
    o[d0]=__builtin_amdgcn_mfma_f32_32x32x16_bf16(pa3,PK(3),o[d0],0,0,0);
    #undef PK
  }
}

#ifndef ATTN_STORE16
#define ATTN_STORE16(p,v) (*(u32x4*)(p)=(v))
#endif
template<int THRL,int LDQ,int LDK,int LDO> __device__ __forceinline__ void attn_unit(const bf16*Qb,const bf16*__restrict__ Kh,const bf16*__restrict__ Vh,bf16*Ob,char*shm){
  int tid=threadIdx.x; asm volatile("":"+v"(tid)); const int lane=tid&63,r32=lane&31,hi=lane>>5; const int wid=__builtin_amdgcn_readfirstlane(tid>>6);
  const bf16*Qw=Qb+(long)(wid*QBLK)*LDQ;
  const unsigned lds0=(unsigned)(uintptr_t)shm;
  float*wsf=(float*)(shm+LDS_WS)+wid*64;
  const bf16*ksrc=Kh+(long)lane*LDK+wid*8;
  const bf16*vsrc=Vh+(long)(16*(wid&3)+(lane>>2))*LDK+(wid>>2)*32+(lane&3)*8;
  const unsigned kdst=lds0+LDS_K+wid*1024, vdst=lds0+LDS_V+wid*1024;
  #define DMA_K(t,slot) glds16(ksrc+(long)(t)*KVBLK*LDK,(unsigned)__builtin_amdgcn_readfirstlane(kdst+(slot)))
  #define DMA_V(t,slot) glds16(vsrc+(long)(t)*KVBLK*LDK,(unsigned)__builtin_amdgcn_readfirstlane(vdst+(slot)))
  const int vb0=(int)(lds0+LDS_V)+((lane>>4)&1)*32+(lane&3)*8+(4*hi+((lane&15)>>2))*64;
  const char*Kbase=shm+LDS_K; bf16x8 kf[8];
  const lds_cptr shm3=(lds_cptr)shm; const lds_cptr kp0=shm3+LDS_K+hi*1024+r32*16; const lds_cptr vp0=shm3+LDS_V+((lane>>4)&1)*32+(lane&3)*8+(4*hi+((lane&15)>>2))*64;
  const int NT=SEQ/KVBLK;
  DMA_K(0,0);DMA_V(0,0);DMA_K(1,SLOTB);
  bf16x8 qr[4];
  #pragma unroll
  for(int d0=0;d0<4;++d0)qr[d0]=*reinterpret_cast<const bf16x8*>(&Qw[(long)r32*LDQ+d0*16+hi*8]);
  float mhat=0.f,l_reg=0.f;f32x16 o[2];o[0]=f32x16{};o[1]=f32x16{};f32x16 negm=f32x16{};asm volatile("":"+v"(negm));
  #define CMASK(P0,P1,t) do{}while(0)
  bool resc=false;
  #define START(P0,P1) do{ const float rm=rowmax(P0,P1); resc=false; \
    { const float dl=rm; mhat=fadd_s(mhat,dl); \
      _Pragma("unroll") for(int r=0;r<16;++r){P0[r]=fsub_s(P0[r],dl);P1[r]=fsub_s(P1[r],dl);} \
      _Pragma("unroll") for(int r=0;r<16;++r)negm[r]=-mhat; asm volatile("":"+v"(negm)); } \
    _Pragma("unroll") for(int r=0;r<16;++r)P0[r]=__builtin_amdgcn_exp2f(P0[r]); }while(0)
  #define RESC() do{ if(resc){ asm volatile("s_waitcnt lgkmcnt(0)":::"memory"); \
      _Pragma("unroll") for(int d_=0;d_<2;++d_) _Pragma("unroll") for(int r=0;r<16;++r)o[d_][r]*=wsf[crow(r,hi)]; } }while(0)
  f32x16 pA0,pA1,pB0,pB1;
  int sl_prev=0,sl_cur=0,sl_next=SLOTB;
  #define ROT() do{sl_prev=sl_cur;sl_cur=sl_next;sl_next=(sl_next==(NSLOT-1)*SLOTB)?0:sl_next+SLOTB;}while(0)
  DMA_K(2,2*SLOTB);
  WAIT_BAR(3);
  qkt(pA0,pA1,Kbase,qr,negm,r32,hi);asm volatile("s_nop 15\n\ts_nop 7":"+v"(pA0),"+v"(pA1));CMASK(pA0,pA1,0);
  START(pA0,pA1);
  _Pragma("unroll") for(int r=0;r<16;++r)pA1[r]=__builtin_amdgcn_exp2f(pA1[r]);
  WAIT_BAR(0);
  DMA_K(3,0);DMA_V(1,SLOTB);
  ROT();
  kload8(kf,kp0+sl_cur);
  WAIT_BAR(2);
  s16x4 vlo[8],vhi[8]; u32x4 pw0,pw1,pw2,pw3;
  #define PKW(P,B) cvtpk_s(P[B],P[B+1])
  #define PAF(k) __builtin_bit_cast(bf16x8,pw##k)
  #define VFR(i) (bf16x8){vlo[i][0],vlo[i][1],vlo[i][2],vlo[i][3],vhi[i][0],vhi[i][1],vhi[i][2],vhi[i][3]}
  #define PIN(x) asm volatile("":"+v"(x))
  #define MX3(a,b,c) __builtin_fmaxf(__builtin_fmaxf((a),(b)),(c))
  #define GAPA(MF,A0,A1,A2,A3,W0,W1,PW) do{ MF; sacc+=A0; sacc+=A1; sacc+=A2; sacc+=A3; PIN(sacc); W0; W1; PIN(PW); SBAR(); }while(0)
  #define EX(v) __builtin_amdgcn_exp2f(v)
  #define GAPB(MF,X,B) do{ MF; X[B]=EX(X[B]); X[B+1]=EX(X[B+1]); X[B+2]=EX(X[B+2]); X[B+3]=EX(X[B+3]); PIN(X); SBAR(); }while(0)
  #define VRD(i) do{ vlo[i]=vtr(vp_+(((i)>>2)*4096+((i)&3)*1024)); vhi[i]=vtr(vp_+(((i)>>2)*4096+((i)&3)*1024+512)); }while(0)
  #define KRD(G,j) do{ if(G){ kload2(kf,kp0+sl_next,j); SBAR(); } }while(0)
  #define STEP(C0,C1,P0,P1,t,GK,GV,GL) do{ SBAR(); \
    const lds_cptr vp_=vp0+sl_prev; \
    VRD(0); SBAR(); float sacc=(P0[0]+P0[1]); \
    GAPA(C0=__builtin_amdgcn_mfma_f32_32x32x16_bf16(kf[0],qr[0],negm,0,0,0), P0[2],P0[3],P0[4],P0[5],     pw0[0]=PKW(P0,0), pw0[1]=PKW(P0,2), pw0); \
    VRD(4); SBAR(); GAPA(C1=__builtin_amdgcn_mfma_f32_32x32x16_bf16(kf[1],qr[0],negm,0,0,0), P0[6],P0[7],P0[8],P0[9],     pw0[2]=PKW(P0,4), pw0[3]=PKW(P0,6), pw0); \
    VRD(1); SBAR(); GAPA(C0=__builtin_amdgcn_mfma_f32_32x32x16_bf16(kf[2],qr[1],C0,0,0,0),   P0[10],P0[11],P0[12],P0[13], pw1[0]=PKW(P0,8), pw1[1]=PKW(P0,10), pw1); \
    VRD(5); SBAR(); GAPA(C1=__builtin_amdgcn_mfma_f32_32x32x16_bf16(kf[3],qr[1],C1,0,0,0),   P0[14],P0[15],P1[0],P1[1],   pw1[2]=PKW(P0,12),pw1[3]=PKW(P0,14), pw1); \
    VRD(2); SBAR(); GAPA(C0=__builtin_amdgcn_mfma_f32_32x32x16_bf16(kf[4],qr[2],C0,0,0,0),   P1[2],P1[3],P1[4],P1[5],     pw2[0]=PKW(P1,0), pw2[1]=PKW(P1,2), pw2); \
    VRD(6); SBAR(); GAPA(C1=__builtin_amdgcn_mfma_f32_32x32x16_bf16(kf[5],qr[2],C1,0,0,0),   P1[6],P1[7],P1[8],P1[9],     pw2[2]=PKW(P1,4), pw2[3]=PKW(P1,6), pw2); \
    VRD(3); SBAR(); GAPA(C0=__builtin_amdgcn_mfma_f32_32x32x16_bf16(kf[6],qr[3],C0,0,0,0),   P1[10],P1[11],P1[12],P1[13], pw3[0]=PKW(P1,8), pw3[1]=PKW(P1,10), pw3); \
    VRD(7); SBAR(); GAPA(C1=__builtin_amdgcn_mfma_f32_32x32x16_bf16(kf[7],qr[3],C1,0,0,0),   P1[14],P1[15],0.f,0.f,       pw3[2]=PKW(P1,12),pw3[3]=PKW(P1,14), pw3); \
    l_reg+=sacc; \
    if(GK){DMA_K((t)+3,sl_cur);} if(GV){DMA_V((t)+1,sl_next);} \
    CMASK(C0,C1,t); \
    { float a=MX3(C0[0],C0[1],C1[0]),b=MX3(C0[2],C0[3],C1[1]); a=MX3(a,C1[2],C1[3]); \
      _Pragma("unroll") for(int r=4;r<16;r+=4){a=MX3(a,C0[r],C0[r+1]);b=MX3(b,C0[r+2],C0[r+3]);a=MX3(a,C1[r],C1[r+1]);b=MX3(b,C1[r+2],C1[r+3]);} \
      float rm=__builtin_fmaxf(a,b); { auto rr=__builtin_amdgcn_permlane32_swap(__float_as_uint(rm),__float_as_uint(rm),false,false); rm=__builtin_fmaxf(__uint_as_float(rr[0]),__uint_as_float(rr[1])); } \
      resc=false; \
      if(__builtin_expect(__any(rm>(float)THRL),0)){ const float dl=__builtin_fmaxf(rm,0.f); mhat+=dl; \
        _Pragma("unroll") for(int r=0;r<16;++r){C0[r]-=dl;C1[r]-=dl;} \
        _Pragma("unroll") for(int r=0;r<16;++r)negm[r]=-mhat; asm volatile("":"+v"(negm)); \
        const float f=__builtin_amdgcn_exp2f(-dl); l_reg*=f; if(hi==0)wsf[r32]=f; resc=true; } } \
    SBAR(); \
    GAPB(o[0]=__builtin_amdgcn_mfma_f32_32x32x16_bf16(PAF(0),VFR(0),o[0],0,0,0), C0,0); \
    GAPB(o[1]=__builtin_amdgcn_mfma_f32_32x32x16_bf16(PAF(0),VFR(4),o[1],0,0,0), C0,4); \
    KRD(GL,0); GAPB(o[0]=__builtin_amdgcn_mfma_f32_32x32x16_bf16(PAF(1),VFR(1),o[0],0,0,0), C0,8); \
    KRD(GL,1); GAPB(o[1]=__builtin_amdgcn_mfma_f32_32x32x16_bf16(PAF(1),VFR(5),o[1],0,0,0), C0,12); \
    KRD(GL,2); GAPB(o[0]=__builtin_amdgcn_mfma_f32_32x32x16_bf16(PAF(2),VFR(2),o[0],0,0,0), C1,0); \
    KRD(GL,3); GAPB(o[1]=__builtin_amdgcn_mfma_f32_32x32x16_bf16(PAF(2),VFR(6),o[1],0,0,0), C1,4); \
    GAPB(o[0]=__builtin_amdgcn_mfma_f32_32x32x16_bf16(PAF(3),VFR(3),o[0],0,0,0), C1,8); \
    GAPB(o[1]=__builtin_amdgcn_mfma_f32_32x32x16_bf16(PAF(3),VFR(7),o[1],0,0,0), C1,12); \
    }while(0)
  int t=1;
  #undef CMASK
  #define CMASK(P0,P1,t) do{}while(0)
  for(;t+5<NT;t+=2){
    STEP(pB0,pB1,pA0,pA1,t,true,true,true);     WAIT_BAR(2); RESC(); ROT();
    STEP(pA0,pA1,pB0,pB1,t+1,true,true,true);   WAIT_BAR(2); RESC(); ROT();
  }
  #undef CMASK
  #define CMASK(P0,P1,t) do{}while(0)
  #define ENDW(tt) do{ if((tt)+3<NT){WAIT_BAR(2);} else if((tt)+2<NT){WAIT_BAR(1);} else {WAIT_BAR(0);} }while(0)
  for(;t+1<NT;t+=2){
    STEP(pB0,pB1,pA0,pA1,t,(t+3<NT),(t+1<NT),(t+1<NT));       ENDW(t);   RESC(); ROT();
    STEP(pA0,pA1,pB0,pB1,t+1,(t+4<NT),(t+2<NT),(t+2<NT));     ENDW(t+1); RESC(); ROT();
  }
  STEP(pB0,pB1,pA0,pA1,NT-1,false,false,false); RESC();
  { float sacc=pB0[0]+pB0[1]; _Pragma("unroll") for(int r=2;r<16;++r)sacc+=pB0[r]; _Pragma("unroll") for(int r=0;r<16;++r)sacc+=pB1[r]; l_reg+=sacc;
    pw0=(u32x4){PKW(pB0,0),PKW(pB0,2),PKW(pB0,4),PKW(pB0,6)};pw1=(u32x4){PKW(pB0,8),PKW(pB0,10),PKW(pB0,12),PKW(pB0,14)};pw2=(u32x4){PKW(pB1,0),PKW(pB1,2),PKW(pB1,4),PKW(pB1,6)};pw3=(u32x4){PKW(pB1,8),PKW(pB1,10),PKW(pB1,12),PKW(pB1,14)};
    SBAR(); pv(o,vb0+sl_cur,PAF(0),PAF(1),PAF(2),PAF(3)); }
  #undef PKW
  #undef PAF
  #undef VFR
  #undef PIN
  #undef MX3
  #undef GAPA
  #undef GAPB
  #undef EX
  #undef VRD
  #undef KRD
  #undef STEP
  #undef ENDW
  {auto rr=__builtin_amdgcn_permlane32_swap(__float_as_uint(l_reg),__float_as_uint(l_reg),false,false);l_reg=__uint_as_float(rr[0])+__uint_as_float(rr[1]);}
  if(hi==0)wsf[32+r32]=l_reg;asm volatile("s_waitcnt lgkmcnt(0)":::"memory");
  float rli[16];
  #pragma unroll
  for(int r=0;r<16;++r)rli[r]=__builtin_amdgcn_rcpf(wsf[32+crow(r,hi)]);
  bf16*Ow=Ob+(long)(wid*QBLK)*LDO;
  { unsigned char*stg=(unsigned char*)(shm+LDS_OST)+wid*4096;
    #pragma unroll
    for(int r=0;r<16;++r){const int orow=crow(r,hi);
      #pragma unroll
      for(int d0=0;d0<2;++d0){const float ov=o[d0][r]*rli[r]; stg[orow*64+d0*32+r32]=(unsigned char)(__builtin_amdgcn_cvt_pk_fp8_f32(ov,ov,0,false)&0xff);}}
    asm volatile("s_waitcnt lgkmcnt(0)":::"memory");
    #pragma unroll
    for(int i=0;i<2;++i){const int row=i*16+(lane>>2),ch=lane&3; const u32x4 v=*(const u32x4*)(stg+row*64+ch*16); ATTN_STORE16((unsigned char*)Ob+(long)(wid*QBLK+row)*LDO+ch*16,v);} }
  asm volatile("s_waitcnt lgkmcnt(0)\n\ts_barrier":::"memory");
  #undef DMA_K
  #undef DMA_V
  #undef CMASK
  #undef START
  #undef RESC
  #undef ROT
}
constexpr int ATTN_LDS_BYTES=LDS_BYTES;
#undef WAIT_BAR
}
namespace att96 {
using bf16=__hip_bfloat16;
using bf16x8=__attribute__((ext_vector_type(8)))short;
using s16x4=__attribute__((ext_vector_type(4)))short;
using f32x16=__attribute__((ext_vector_type(16)))float;
using u32x4=__attribute__((ext_vector_type(4)))unsigned;
constexpr int SEQ=8192,D=64,NW=8,QBLK=32,QB=QBLK*NW,KVBLK=64;
__device__ __forceinline__ int crow(int r,int hi){return (r&3)+8*(r>>2)+4*hi;}
constexpr int NSLOT=3, SLOTB=8192, KSLOT=12288;
constexpr int LDS_K=0, LDS_V=NSLOT*KSLOT, LDS_WS=NSLOT*KSLOT+NSLOT*SLOTB, LDS_OST=LDS_WS+NW*64*4, LDS_BYTES=LDS_OST+NW*4096;
constexpr float C2=0.125f*1.4426950408889634f;
__device__ __forceinline__ void glds16(const void*gsrc,unsigned lds_dst){unsigned keep;
  asm volatile("s_mov_b32 %0, m0\n\ts_mov_b32 m0, %2\n\ts_nop 0\n\tglobal_load_lds_dwordx4 %1, off\n\ts_mov_b32 m0, %0":"=&s"(keep):"v"(gsrc),"s"(lds_dst):"memory");}
__device__ __forceinline__ float max3f(float a,float b,float c){float r;asm("v_max3_f32 %0, %1, %2, %3":"=v"(r):"v"(a),"v"(b),"v"(c));return r;}
__device__ __forceinline__ float max2f(float a,float b){float r;asm("v_max_f32_e32 %0, %1, %2":"=v"(r):"v"(a),"v"(b));return r;}
__device__ __forceinline__ float fadd_s(float a,float b){float r;asm("v_add_f32_e32 %0, %1, %2":"=v"(r):"v"(a),"v"(b));return r;}
__device__ __forceinline__ float fsub_s(float a,float b){float r;asm("v_sub_f32_e32 %0, %1, %2":"=v"(r):"v"(a),"v"(b));return r;}
typedef float f32x2_t __attribute__((ext_vector_type(2))); typedef __bf16 bf16x2_t __attribute__((ext_vector_type(2)));
__device__ __forceinline__ unsigned cvtpk_s(float lo,float hi){f32x2_t v={lo,hi};bf16x2_t b=__builtin_convertvector(v,bf16x2_t);return __builtin_bit_cast(unsigned,b);}
#define WAIT_BAR(N) asm volatile("s_waitcnt vmcnt(" #N ") lgkmcnt(0)\n\ts_barrier":::"memory")

__device__ __forceinline__ void qkt(f32x16&p0,f32x16&p1,const char*Kslot,const bf16x8*qr,const f32x16&negm,int r32,int hi){
  const char*kb=Kslot+hi*1024+r32*16;
  #pragma unroll
  for(int d0=0;d0<6;++d0){
    const bf16x8 b0=*reinterpret_cast<const bf16x8*>(kb+d0*2048);
    const bf16x8 b1=*reinterpret_cast<const bf16x8*>(kb+d0*2048+512);
    if(d0==0){p0=__builtin_amdgcn_mfma_f32_32x32x16_bf16(b0,qr[0],negm,0,0,0);p1=__builtin_amdgcn_mfma_f32_32x32x16_bf16(b1,qr[0],negm,0,0,0);}
    else{p0=__builtin_amdgcn_mfma_f32_32x32x16_bf16(b0,qr[d0],p0,0,0,0);p1=__builtin_amdgcn_mfma_f32_32x32x16_bf16(b1,qr[d0],p1,0,0,0);}}
}
typedef __attribute__((address_space(3))) const char* lds_cptr;
typedef short v4i16_t __attribute__((ext_vector_type(4)));
__device__ __forceinline__ void kload8(bf16x8*kf,lds_cptr kp){
  kf[0]=*(const __attribute__((address_space(3))) bf16x8*)(kp);      kf[1]=*(const __attribute__((address_space(3))) bf16x8*)(kp+512);
  kf[2]=*(const __attribute__((address_space(3))) bf16x8*)(kp+2048); kf[3]=*(const __attribute__((address_space(3))) bf16x8*)(kp+2560);
  kf[4]=*(const __attribute__((address_space(3))) bf16x8*)(kp+4096); kf[5]=*(const __attribute__((address_space(3))) bf16x8*)(kp+4608);
  kf[6]=*(const __attribute__((address_space(3))) bf16x8*)(kp+6144); kf[7]=*(const __attribute__((address_space(3))) bf16x8*)(kp+6656);
  kf[8]=*(const __attribute__((address_space(3))) bf16x8*)(kp+8192); kf[9]=*(const __attribute__((address_space(3))) bf16x8*)(kp+8704);
  kf[10]=*(const __attribute__((address_space(3))) bf16x8*)(kp+10240); kf[11]=*(const __attribute__((address_space(3))) bf16x8*)(kp+10752);
}
__device__ __forceinline__ void kload2(bf16x8*kf,lds_cptr kp,int j){ kf[2*j]=*(const __attribute__((address_space(3))) bf16x8*)(kp+j*2048); kf[2*j+1]=*(const __attribute__((address_space(3))) bf16x8*)(kp+j*2048+512); }
__device__ __forceinline__ s16x4 vtr(lds_cptr p){ return __builtin_bit_cast(s16x4,__builtin_amdgcn_ds_read_tr16_b64_v4i16((__attribute__((address_space(3))) v4i16_t*)p)); }
__device__ __forceinline__ float rowmax(const f32x16&p0,const f32x16&p1){
  float a=max3f(p0[0],p0[1],p1[0]),b=max3f(p0[2],p0[3],p1[1]);a=max3f(a,p1[2],p1[3]);
  #pragma unroll
  for(int r=4;r<16;r+=4){a=max3f(a,p0[r],p0[r+1]);b=max3f(b,p0[r+2],p0[r+3]);a=max3f(a,p1[r],p1[r+1]);b=max3f(b,p1[r+2],p1[r+3]);}
  const float m=max2f(a,b);
  auto rr=__builtin_amdgcn_permlane32_swap(__float_as_uint(m),__float_as_uint(m),false,false);
  return max2f(__uint_as_float(rr[0]),__uint_as_float(rr[1]));
}
__device__ __forceinline__ void pv(f32x16*o,int vb,bf16x8 pa0,bf16x8 pa1,bf16x8 pa2,bf16x8 pa3){
  #pragma unroll
  for(int d0=0;d0<2;++d0){s16x4 lo[4],hi[4];
    #pragma unroll
    for(int ks=0;ks<4;++ks){
      asm volatile("ds_read_b64_tr_b16 %0,%1 offset:%c2":"=&v"(lo[ks]):"v"(vb),"i"(d0*4096+ks*1024):"memory");
      asm volatile("ds_read_b64_tr_b16 %0,%1 offset:%c2":"=&v"(hi[ks]):"v"(vb),"i"(d0*4096+ks*1024+512):"memory");}
    asm volatile("s_waitcnt lgkmcnt(0)":::"memory");SBAR();
    #define PK(k) (bf16x8){lo[k][0],lo[k][1],lo[k][2],lo[k][3],hi[k][0],hi[k][1],hi[k][2],hi[k][3]}
    o[d0]=__builtin_amdgcn_mfma_f32_32x32x16_bf16(pa0,PK(0),o[d0],0,0,0);
    o[d0]=__builtin_amdgcn_mfma_f32_32x32x16_bf16(pa1,PK(1),o[d0],0,0,0);
    o[d0]=__builtin_amdgcn_mfma_f32_32x32x16_bf16(pa2,PK(2),o[d0],0,0,0);
    o[d0]=__builtin_amdgcn_mfma_f32_32x32x16_bf16(pa3,PK(3),o[d0],0,0,0);
    #undef PK
  }
}

#ifndef ATTN_STORE16
#define ATTN_STORE16(p,v) (*(u32x4*)(p)=(v))
#endif
template<int THRL,int LDQ,int LDK,int LDV,int LDO> __device__ __forceinline__ void attn_unit(const bf16*Qb,const bf16*__restrict__ Kh,const bf16*__restrict__ Vh,bf16*Ob,char*shm){
  int tid=threadIdx.x; asm volatile("":"+v"(tid)); const int lane=tid&63,r32=lane&31,hi=lane>>5; const int wid=__builtin_amdgcn_readfirstlane(tid>>6);
  const bf16*Qw=Qb+(long)(wid*QBLK)*LDQ;
  const unsigned lds0=(unsigned)(uintptr_t)shm;
  float*wsf=(float*)(shm+LDS_WS)+wid*64;
  const bf16*ksrc=Kh+(long)lane*LDK+wid*8;
  const bf16*vsrc=Vh+(long)(16*(wid&3)+(lane>>2))*LDV+(wid>>2)*32+(lane&3)*8;
  const bf16*ksrc2=Kh+(long)lane*LDK+(8+(wid&3))*8;
  const unsigned kdst=lds0+LDS_K+wid*1024, kdst2=lds0+LDS_K+(8+(wid&3))*1024, vdst=lds0+LDS_V+wid*1024;
  #define KOFF(s) ((s)+((s)>>1))
  #define DMA_K(t,slot) do{ glds16(ksrc+(long)(t)*KVBLK*LDK,(unsigned)__builtin_amdgcn_readfirstlane(kdst+KOFF(slot))); glds16(ksrc2+(long)(t)*KVBLK*LDK,(unsigned)__builtin_amdgcn_readfirstlane(kdst2+KOFF(slot))); }while(0)
  #define DMA_V(t,slot) glds16(vsrc+(long)(t)*KVBLK*LDV,(unsigned)__builtin_amdgcn_readfirstlane(vdst+(slot)))
  const int vb0=(int)(lds0+LDS_V)+((lane>>4)&1)*32+(lane&3)*8+(4*hi+((lane&15)>>2))*64;
  const char*Kbase=shm+LDS_K; bf16x8 kf[12];
  const lds_cptr shm3=(lds_cptr)shm; const lds_cptr kp0=shm3+LDS_K+hi*1024+r32*16; const lds_cptr vp0=shm3+LDS_V+((lane>>4)&1)*32+(lane&3)*8+(4*hi+((lane&15)>>2))*64;
  const int NT=SEQ/KVBLK;
  DMA_K(0,0);DMA_V(0,0);DMA_K(1,SLOTB);
  bf16x8 qr[6];
  #pragma unroll
  for(int d0=0;d0<6;++d0)qr[d0]=*reinterpret_cast<const bf16x8*>(&Qw[(long)r32*LDQ+d0*16+hi*8]);
  float mhat=0.f,l_reg=0.f;f32x16 o[2];o[0]=f32x16{};o[1]=f32x16{};f32x16 negm=f32x16{};asm volatile("":"+v"(negm));
  #define CMASK(P0,P1,t) do{}while(0)
  bool resc=false;
  #define START(P0,P1) do{ const float rm=rowmax(P0,P1); resc=false; \
    { const float dl=rm; mhat=fadd_s(mhat,dl); \
      _Pragma("unroll") for(int r=0;r<16;++r){P0[r]=fsub_s(P0[r],dl);P1[r]=fsub_s(P1[r],dl);} \
      _Pragma("unroll") for(int r=0;r<16;++r)negm[r]=-mhat; asm volatile("":"+v"(negm)); } \
    _Pragma("unroll") for(int r=0;r<16;++r)P0[r]=__builtin_amdgcn_exp2f(P0[r]); }while(0)
  #define RESC() do{ if(resc){ asm volatile("s_waitcnt lgkmcnt(0)":::"memory"); \
      _Pragma("unroll") for(int d_=0;d_<2;++d_) _Pragma("unroll") for(int r=0;r<16;++r)o[d_][r]*=wsf[crow(r,hi)]; } }while(0)
  f32x16 pA0,pA1,pB0,pB1;
  int sl_prev=0,sl_cur=0,sl_next=SLOTB;
  #define ROT() do{sl_prev=sl_cur;sl_cur=sl_next;sl_next=(sl_next==(NSLOT-1)*SLOTB)?0:sl_next+SLOTB;}while(0)
  DMA_K(2,2*SLOTB);
  WAIT_BAR(5);
  qkt(pA0,pA1,Kbase,qr,negm,r32,hi);asm volatile("s_nop 15\n\ts_nop 7":"+v"(pA0),"+v"(pA1));CMASK(pA0,pA1,0);
  START(pA0,pA1);
  _Pragma("unroll") for(int r=0;r<16;++r)pA1[r]=__builtin_amdgcn_exp2f(pA1[r]);
  WAIT_BAR(0);
  DMA_K(3,0);DMA_V(1,SLOTB);
  ROT();
  kload8(kf,kp0+KOFF(sl_cur));
  WAIT_BAR(3);
  s16x4 vlo[8],vhi[8]; u32x4 pw0,pw1,pw2,pw3;
  #define PKW(P,B) cvtpk_s(P[B],P[B+1])
  #define PAF(k) __builtin_bit_cast(bf16x8,pw##k)
  #define VFR(i) (bf16x8){vlo[i][0],vlo[i][1],vlo[i][2],vlo[i][3],vhi[i][0],vhi[i][1],vhi[i][2],vhi[i][3]}
  #define PIN(x) asm volatile("":"+v"(x))
  #define MX3(a,b,c) __builtin_fmaxf(__builtin_fmaxf((a),(b)),(c))
  #define GAPA(MF,A0,A1,A2,A3,W0,W1,PW) do{ MF; sacc+=A0; sacc+=A1; sacc+=A2; sacc+=A3; PIN(sacc); W0; W1; PIN(PW); SBAR(); }while(0)
  #define GAPX(MF,ADDS,PACKS,PW) do{ MF; ADDS; PIN(sacc); PACKS; PIN(PW); SBAR(); }while(0)
  #define EX(v) __builtin_amdgcn_exp2f(v)
  #define GAPB(MF,X,B) do{ MF; X[B]=EX(X[B]); X[B+1]=EX(X[B+1]); X[B+2]=EX(X[B+2]); X[B+3]=EX(X[B+3]); PIN(X); SBAR(); }while(0)
  #define VRD(i) do{ vlo[i]=vtr(vp_+(((i)>>2)*4096+((i)&3)*1024)); vhi[i]=vtr(vp_+(((i)>>2)*4096+((i)&3)*1024+512)); }while(0)
  #define KRD(G,j) do{ if(G){ kload2(kf,kp0+KOFF(sl_next),j); SBAR(); } }while(0)
  #define STEP(C0,C1,P0,P1,t,GK,GV,GL) do{ SBAR(); \
    const lds_cptr vp_=vp0+sl_prev; \
    VRD(0); SBAR(); float sacc=(P0[0]+P0[1]); \
    GAPX(C0=__builtin_amdgcn_mfma_f32_32x32x16_bf16(kf[0],qr[0],negm,0,0,0), sacc+=P0[2];sacc+=P0[3];sacc+=P0[4],    pw0[0]=PKW(P0,0);pw0[1]=PKW(P0,2), pw0); \
    VRD(4); SBAR(); GAPX(C1=__builtin_amdgcn_mfma_f32_32x32x16_bf16(kf[1],qr[0],negm,0,0,0), sacc+=P0[5];sacc+=P0[6];sacc+=P0[7],    pw0[2]=PKW(P0,4);pw0[3]=PKW(P0,6), pw0); \
    VRD(1); SBAR(); GAPX(C0=__builtin_amdgcn_mfma_f32_32x32x16_bf16(kf[2],qr[1],C0,0,0,0),   sacc+=P0[8];sacc+=P0[9];sacc+=P0[10],   pw1[0]=PKW(P0,8);pw1[1]=PKW(P0,10), pw1); \
    VRD(5); SBAR(); GAPX(C1=__builtin_amdgcn_mfma_f32_32x32x16_bf16(kf[3],qr[1],C1,0,0,0),   sacc+=P0[11];sacc+=P0[12];sacc+=P0[13], pw1[2]=PKW(P0,12);pw1[3]=PKW(P0,14), pw1); \
    VRD(2); SBAR(); GAPX(C0=__builtin_amdgcn_mfma_f32_32x32x16_bf16(kf[4],qr[2],C0,0,0,0),   sacc+=P0[14];sacc+=P0[15];sacc+=P1[0],  pw2[0]=PKW(P1,0), pw2); \
    VRD(6); SBAR(); GAPX(C1=__builtin_amdgcn_mfma_f32_32x32x16_bf16(kf[5],qr[2],C1,0,0,0),   sacc+=P1[1];sacc+=P1[2];sacc+=P1[3],    pw2[1]=PKW(P1,2), pw2); \
    VRD(3); SBAR(); GAPX(C0=__builtin_amdgcn_mfma_f32_32x32x16_bf16(kf[6],qr[3],C0,0,0,0),   sacc+=P1[4];sacc+=P1[5],                pw2[2]=PKW(P1,4), pw2); \
    VRD(7); SBAR(); GAPX(C1=__builtin_amdgcn_mfma_f32_32x32x16_bf16(kf[7],qr[3],C1,0,0,0),   sacc+=P1[6];sacc+=P1[7],                pw2[3]=PKW(P1,6), pw2); \
    GAPX(C0=__builtin_amdgcn_mfma_f32_32x32x16_bf16(kf[8],qr[4],C0,0,0,0),  sacc+=P1[8];sacc+=P1[9],   pw3[0]=PKW(P1,8), pw3); \
    GAPX(C1=__builtin_amdgcn_mfma_f32_32x32x16_bf16(kf[9],qr[4],C1,0,0,0),  sacc+=P1[10];sacc+=P1[11], pw3[1]=PKW(P1,10), pw3); \
    GAPX(C0=__builtin_amdgcn_mfma_f32_32x32x16_bf16(kf[10],qr[5],C0,0,0,0), sacc+=P1[12];sacc+=P1[13], pw3[2]=PKW(P1,12), pw3); \
    GAPX(C1=__builtin_amdgcn_mfma_f32_32x32x16_bf16(kf[11],qr[5],C1,0,0,0), sacc+=P1[14];sacc+=P1[15], pw3[3]=PKW(P1,14), pw3); \
    l_reg+=sacc; \
    if(GK){DMA_K((t)+3,sl_cur);} if(GV){DMA_V((t)+1,sl_next);} \
    CMASK(C0,C1,t); \
    { float a=MX3(C0[0],C0[1],C1[0]),b=MX3(C0[2],C0[3],C1[1]); a=MX3(a,C1[2],C1[3]); \
      _Pragma("unroll") for(int r=4;r<16;r+=4){a=MX3(a,C0[r],C0[r+1]);b=MX3(b,C0[r+2],C0[r+3]);a=MX3(a,C1[r],C1[r+1]);b=MX3(b,C1[r+2],C1[r+3]);} \
      float rm=__builtin_fmaxf(a,b); { auto rr=__builtin_amdgcn_permlane32_swap(__float_as_uint(rm),__float_as_uint(rm),false,false); rm=__builtin_fmaxf(__uint_as_float(rr[0]),__uint_as_float(rr[1])); } \
      resc=false; \
      if(__builtin_expect(__any(rm>(float)THRL),0)){ const float dl=__builtin_fmaxf(rm,0.f); mhat+=dl; \
        _Pragma("unroll") for(int r=0;r<16;++r){C0[r]-=dl;C1[r]-=dl;} \
        _Pragma("unroll") for(int r=0;r<16;++r)negm[r]=-mhat; asm volatile("":"+v"(negm)); \
        const float f=__builtin_amdgcn_exp2f(-dl); l_reg*=f; if(hi==0)wsf[r32]=f; resc=true; } } \
    SBAR(); \
    GAPB(o[0]=__builtin_amdgcn_mfma_f32_32x32x16_bf16(PAF(0),VFR(0),o[0],0,0,0), C0,0); \
    GAPB(o[1]=__builtin_amdgcn_mfma_f32_32x32x16_bf16(PAF(0),VFR(4),o[1],0,0,0), C0,4); \
    KRD(GL,0); GAPB(o[0]=__builtin_amdgcn_mfma_f32_32x32x16_bf16(PAF(1),VFR(1),o[0],0,0,0), C0,8); \
    KRD(GL,1); GAPB(o[1]=__builtin_amdgcn_mfma_f32_32x32x16_bf16(PAF(1),VFR(5),o[1],0,0,0), C0,12); \
    KRD(GL,2); GAPB(o[0]=__builtin_amdgcn_mfma_f32_32x32x16_bf16(PAF(2),VFR(2),o[0],0,0,0), C1,0); \
    KRD(GL,3); GAPB(o[1]=__builtin_amdgcn_mfma_f32_32x32x16_bf16(PAF(2),VFR(6),o[1],0,0,0), C1,4); \
    KRD(GL,4); GAPB(o[0]=__builtin_amdgcn_mfma_f32_32x32x16_bf16(PAF(3),VFR(3),o[0],0,0,0), C1,8); \
    KRD(GL,5); GAPB(o[1]=__builtin_amdgcn_mfma_f32_32x32x16_bf16(PAF(3),VFR(7),o[1],0,0,0), C1,12); \
    }while(0)
  int t=1;
  #undef CMASK
  #define CMASK(P0,P1,t) do{}while(0)
  for(;t+5<NT;t+=2){
    STEP(pB0,pB1,pA0,pA1,t,true,true,true);     WAIT_BAR(3); RESC(); ROT();
    STEP(pA0,pA1,pB0,pB1,t+1,true,true,true);   WAIT_BAR(3); RESC(); ROT();
  }
  #undef CMASK
  #define CMASK(P0,P1,t) do{}while(0)
  #define ENDW(tt) do{ if((tt)+3<NT){WAIT_BAR(3);} else if((tt)+2<NT){WAIT_BAR(1);} else {WAIT_BAR(0);} }while(0)
  for(;t+1<NT;t+=2){
    STEP(pB0,pB1,pA0,pA1,t,(t+3<NT),(t+1<NT),(t+1<NT));       ENDW(t);   RESC(); ROT();
    STEP(pA0,pA1,pB0,pB1,t+1,(t+4<NT),(t+2<NT),(t+2<NT));     ENDW(t+1); RESC(); ROT();
  }
  STEP(pB0,pB1,pA0,pA1,NT-1,false,false,false); RESC();
  { float sacc=pB0[0]+pB0[1]; _Pragma("unroll") for(int r=2;r<16;++r)sacc+=pB0[r]; _Pragma("unroll") for(int r=0;r<16;++r)sacc+=pB1[r]; l_reg+=sacc;
    pw0=(u32x4){PKW(pB0,0),PKW(pB0,2),PKW(pB0,4),PKW(pB0,6)};pw1=(u32x4){PKW(pB0,8),PKW(pB0,10),PKW(pB0,12),PKW(pB0,14)};pw2=(u32x4){PKW(pB1,0),PKW(pB1,2),PKW(pB1,4),PKW(pB1,6)};pw3=(u32x4){PKW(pB1,8),PKW(pB1,10),PKW(pB1,12),PKW(pB1,14)};
    SBAR(); pv(o,vb0+sl_cur,PAF(0),PAF(1),PAF(2),PAF(3)); }
  #undef PKW
  #undef PAF
  #undef VFR
  #undef PIN
  #undef MX3
  #undef GAPA
  #undef GAPX
  #undef GAPB
  #undef EX
  #undef VRD
  #undef KRD
  #undef STEP
  #undef ENDW
  {auto rr=__builtin_amdgcn_permlane32_swap(__float_as_uint(l_reg),__float_as_uint(l_reg),false,false);l_reg=__uint_as_float(rr[0])+__uint_as_float(rr[1]);}
  if(hi==0)wsf[32+r32]=l_reg;asm volatile("s_waitcnt lgkmcnt(0)":::"memory");
  float rli[16];
  #pragma unroll
  for(int r=0;r<16;++r)rli[r]=__builtin_amdgcn_rcpf(wsf[32+crow(r,hi)]);
  bf16*Ow=Ob+(long)(wid*QBLK)*LDO;
  { unsigned char*stg=(unsigned char*)(shm+LDS_OST)+wid*4096;
    #pragma unroll
    for(int r=0;r<16;++r){const int orow=crow(r,hi);
      #pragma unroll
      for(int d0=0;d0<2;++d0){const float ov=o[d0][r]*rli[r]; stg[orow*64+d0*32+r32]=(unsigned char)(__builtin_amdgcn_cvt_pk_fp8_f32(ov,ov,0,false)&0xff);}}
    asm volatile("s_waitcnt lgkmcnt(0)":::"memory");
    #pragma unroll
    for(int i=0;i<2;++i){const int row=i*16+(lane>>2),ch=lane&3; const u32x4 v=*(const u32x4*)(stg+row*64+ch*16); ATTN_STORE16((unsigned char*)Ob+(long)(wid*QBLK+row)*LDO+ch*16,v);} }
  asm volatile("s_waitcnt lgkmcnt(0)\n\ts_barrier":::"memory");
  #undef DMA_K
  #undef DMA_V
  #undef CMASK
  #undef START
  #undef RESC
  #undef ROT
}
constexpr int ATTN_LDS_BYTES=LDS_BYTES;
#undef WAIT_BAR
#undef KOFF
}
#define RLX_AGENT __ATOMIC_RELAXED, __HIP_MEMORY_SCOPE_AGENT
#define XB_TMO      128
#define XB_XCNT(j)  (256  + 64 * (j))
#define XB_XSUB(j)  (1280 + 64 * (j))
#define XB_XGEN(j)  (2304 + 64 * (j))
#define XB_TOP      3328
#define XB_TOPGEN   3392
#define XCD_BAR_WORDS 3456
#define XB_SPIN_CAP (1u << 18)

__device__ __forceinline__ unsigned xb_ld(unsigned* p)              { return __hip_atomic_load(p, __ATOMIC_RELAXED, __HIP_MEMORY_SCOPE_AGENT); }
__device__ __forceinline__ unsigned xb_add(unsigned* p, unsigned v) { return __hip_atomic_fetch_add(p, v, __ATOMIC_RELAXED, __HIP_MEMORY_SCOPE_AGENT); }
__device__ __forceinline__ unsigned xb_xcc_id() { return (unsigned)__builtin_amdgcn_s_getreg((3 << 11) | 20) & 0xFu; }
#define XB_SPIN(cond, bar) do { unsigned _sp = 0; while (cond) { __builtin_amdgcn_s_sleep(1); \
    if ((++_sp & 255u) == 0u) { if (xb_ld(&(bar)[XB_TMO])) break; if (_sp > XB_SPIN_CAP) { atomicAdd(&(bar)[XB_TMO], 1u); break; } } } } while (0)

struct XcdBarrier {
    unsigned* bar; unsigned x;
    volatile LAS unsigned* st;
};

__device__ __forceinline__ XcdBarrier xcd_barrier_post(unsigned* bar, volatile LAS unsigned* st) {
    XcdBarrier b; b.bar = bar; b.x = xb_xcc_id(); b.st = st;
    if (threadIdx.x == 0) (void)xb_add(&bar[XB_XCNT(b.x)], 1u);
    return b;
}
__device__ __forceinline__ void xcd_barrier_complete(unsigned* bar, unsigned x, unsigned& nloc, unsigned& nx) {
    const unsigned G = gridDim.x * gridDim.y * gridDim.z;
    unsigned sum, cnt, mine, sp = 0u;
    for (;;) {
        sum = 0u; cnt = 0u; mine = 0u;
#pragma unroll
        for (unsigned j = 0; j < 16; ++j) { const unsigned c = xb_ld(&bar[XB_XCNT(j)]); sum += c; cnt += (c > 0u) ? 1u : 0u; mine = (j == x) ? c : mine; }
        if (sum == G) break;
        __builtin_amdgcn_s_sleep(1);
        if ((++sp & 255u) == 0u) { if (xb_ld(&bar[XB_TMO])) break; if (sp > XB_SPIN_CAP) { atomicAdd(&bar[XB_TMO], 1u); break; } }
    }
    nloc = mine > 0u ? mine : 1u; nx = cnt > 0u ? cnt : 1u;
}

__device__ __forceinline__ void xcd_barrier(const XcdBarrier& b) {
    asm volatile("s_waitcnt vmcnt(0)" ::: "memory");
    __syncthreads();
    if (threadIdx.x == 0) {
        unsigned* bar = b.bar;
        __builtin_amdgcn_s_waitcnt(0);
        unsigned nloc = b.st[0], nx = b.st[1];
        if (nloc == 0u) { xcd_barrier_complete(bar, b.x, nloc, nx); b.st[0] = nloc; b.st[1] = nx; }
        const unsigned old = xb_add(&bar[XB_XSUB(b.x)], 1u);
        const unsigned gen = old / nloc;
        if (old + 1u == (gen + 1u) * nloc) {
            __builtin_amdgcn_fence(__ATOMIC_RELEASE, "agent");
            asm volatile("s_waitcnt vmcnt(0)" ::: "memory");
            const unsigned og = xb_add(&bar[XB_TOP], 1u);
            const unsigned tg = og / nx;
            if (og + 1u == (tg + 1u) * nx) xb_add(&bar[XB_TOPGEN], 1u);
            else XB_SPIN(xb_ld(&bar[XB_TOPGEN]) == tg, bar);
            __builtin_amdgcn_fence(__ATOMIC_ACQUIRE, "agent");
            xb_add(&bar[XB_XGEN(b.x)], 1u);
            asm volatile("s_waitcnt vmcnt(0)" ::: "memory");
        } else {
            XB_SPIN(xb_ld(&bar[XB_XGEN(b.x)]) == gen, bar);
            __builtin_amdgcn_fence(__ATOMIC_ACQUIRE, "agent");
            asm volatile("s_waitcnt vmcnt(0)" ::: "memory");
        }
    }
    __syncthreads();
}
constexpr size_t MiB = 1u << 20;
constexpr size_t WS_CTL = 0, CTL_ZERO_BYTES = 1 * MiB;
constexpr int CW_BAR = 4096;
constexpr size_t WS_MOD = 512 * 1024;
constexpr size_t WS_WIN = 1 * MiB;
constexpr size_t WS_WUQ = 43 * MiB;
constexpr size_t WS_WUKV = 45 * MiB;
constexpr size_t WS_WP = 46 * MiB;
constexpr size_t WS_WOUT = 58 * MiB;
constexpr size_t WS_WQ = 66 * MiB;
constexpr size_t WS_SUBK = 82 * MiB;
constexpr size_t WS_WSS = 84 * MiB;
constexpr size_t WS_ROPE = 85 * MiB;
constexpr size_t WS_PU = 88 * MiB, WS_PV = 216 * MiB;
constexpr size_t WS_X = 344 * MiB;
constexpr size_t WS_H = 408 * MiB;
constexpr size_t WS_Z = 440 * MiB;
constexpr size_t WS_YA = 608 * MiB;
constexpr size_t WS_QB = 656 * MiB, WS_KB = 672 * MiB, WS_VB = 676 * MiB;
constexpr size_t WS_CQN = 680 * MiB, WS_CKVN = 688 * MiB;
constexpr size_t WS_QC = 692 * MiB, WS_KC = 716 * MiB, WS_VC = 740 * MiB;
constexpr size_t WS_MF = 756 * MiB, WS_MB = 820 * MiB;
constexpr size_t WS_QP = 852 * MiB;
constexpr size_t WS_IDS = 916 * MiB, WS_GW = 924 * MiB;
constexpr size_t WS_SP = WS_Z;
constexpr size_t WS_W = 932 * MiB;
constexpr size_t WS_HQ = 940 * MiB;
constexpr size_t WS_HS = 956 * MiB;
constexpr size_t WS_WSC = 957 * MiB;
constexpr size_t WS_G8 = 958 * MiB;
constexpr size_t WS_END = 1006 * MiB;

constexpr int NWAVES = 8;
constexpr int LDS_BYTES = 147456;
constexpr int MISC_OFF = 131072;

#define DPP_ADD(v, ctrl) ((v) + __int_as_float(__builtin_amdgcn_update_dpp(0, __float_as_int(v), (ctrl), 0xF, 0xF, true)))
__device__ __forceinline__ float sum4(float v) { v = DPP_ADD(v, 0xB1); v = DPP_ADD(v, 0x4E); return v; }
__device__ __forceinline__ float sum8(float v) { v = sum4(v); v = DPP_ADD(v, 0x141); return v; }
__device__ __forceinline__ float sum16(float v) { v = sum8(v); v = DPP_ADD(v, 0x140); return v; }
__device__ __forceinline__ float xor16_add(float v) { return v + __int_as_float(__builtin_amdgcn_ds_swizzle(__float_as_int(v), 0x401F)); }
__device__ __forceinline__ float xor32_add(float v) { auto rr = __builtin_amdgcn_permlane32_swap(__float_as_uint(v), __float_as_uint(v), false, false); return __uint_as_float(rr[0]) + __uint_as_float(rr[1]); }
__device__ __forceinline__ float sum32(float v) { return xor16_add(sum16(v)); }
__device__ __forceinline__ float wave_sum(float v) { return xor32_add(sum32(v)); }
__device__ __forceinline__ void unpack8(u32x4 w, float* x) { x[0] = bf_lo(w.x); x[1] = bf_hi(w.x); x[2] = bf_lo(w.y); x[3] = bf_hi(w.y); x[4] = bf_lo(w.z); x[5] = bf_hi(w.z); x[6] = bf_lo(w.w); x[7] = bf_hi(w.w); }
__device__ __forceinline__ u32x4 pack8f(const float* x) { u32x4 w; w.x = cvtpk(x[0], x[1]); w.y = cvtpk(x[2], x[3]); w.z = cvtpk(x[4], x[5]); w.w = cvtpk(x[6], x[7]); return w; }

__device__ __forceinline__ unsigned pack4_fp8(float a, float b, float c, float d);
__device__ __forceinline__ void p0_transpose_item(const float* W, int K, int N, bf16_t* WT, int ldw, LAS float* scr, int item, int lane, float f8sc = 0.f) {
    const int nblk = N / 32, kb = item / nblk, nb = item % nblk, k0 = 64 * kb, n0 = 32 * nb;
#pragma unroll 8
    for (int i = 0; i < 32; ++i) { const int kk = 2 * i + (lane >> 5); scr[kk * 33 + (lane & 31)] = W[(size_t)(k0 + kk) * N + n0 + (lane & 31)]; }
    asm volatile("s_waitcnt lgkmcnt(0)" ::: "memory");
    const int c = lane & 7;
#pragma unroll
    for (int j = 0; j < 4; ++j) { const int n = (lane >> 3) + 8 * j; const LAS float* s = scr + (8 * c) * 33 + n;
        if (f8sc != 0.f) { u32x2 o8; o8.x = pack4_fp8(s[0 * 33] * f8sc, s[1 * 33] * f8sc, s[2 * 33] * f8sc, s[3 * 33] * f8sc); o8.y = pack4_fp8(s[4 * 33] * f8sc, s[5 * 33] * f8sc, s[6 * 33] * f8sc, s[7 * 33] * f8sc);
            *(u32x2*)((unsigned char*)WT + (size_t)(n0 + n) * ldw + k0 + 8 * c) = o8; continue; }
        u32x4 o; o.x = cvtpk(s[0 * 33], s[1 * 33]); o.y = cvtpk(s[2 * 33], s[3 * 33]); o.z = cvtpk(s[4 * 33], s[5 * 33]); o.w = cvtpk(s[6 * 33], s[7 * 33]);
        *(u32x4*)(WT + (size_t)(n0 + n) * ldw + k0 + 8 * c) = o; }
    asm volatile("s_waitcnt lgkmcnt(0)" ::: "memory");
}
__device__ __forceinline__ void cvt_flat(const float* src, bf16_t* dst, size_t n8, size_t gtid, size_t gthreads) {
    for (size_t i = gtid; i < n8; i += gthreads) {
        const f32x4 a = *(const f32x4*)(src + i * 8), b = *(const f32x4*)(src + i * 8 + 4);
        u32x4 w; w.x = cvtpk(a[0], a[1]); w.y = cvtpk(a[2], a[3]); w.z = cvtpk(b[0], b[1]); w.w = cvtpk(b[2], b[3]);
        *(u32x4*)(dst + i * 8) = w;
    }
}

constexpr float PEER_SCU = 512.f, PEER_SCV = 16.f;
__device__ __forceinline__ unsigned pack4_fp8(float a, float b, float c, float d) { int p = 0; p = __builtin_amdgcn_cvt_pk_fp8_f32(a, b, p, false); p = __builtin_amdgcn_cvt_pk_fp8_f32(c, d, p, true); return (unsigned)p; }
__device__ __forceinline__ void unpack16_fp8(u32x4 w, float* x) {
#pragma unroll
    for (int q = 0; q < 4; ++q) { const f32x2_t lo = __builtin_amdgcn_cvt_pk_f32_fp8((int)w[q], false), hi = __builtin_amdgcn_cvt_pk_f32_fp8((int)w[q], true);
        x[4 * q] = lo.x; x[4 * q + 1] = lo.y; x[4 * q + 2] = hi.x; x[4 * q + 3] = hi.y; }
}
__device__ __forceinline__ void cvt_sliced_fp8(const float* src, unsigned char* dst, float sc, size_t gtid, size_t gthreads) {
    for (size_t i = gtid; i < (size_t)NLAYER * 16384 * 64; i += gthreads) {
        const size_t le = i >> 6, ch = i & 63, l = le >> 14, e = le & 16383;
        const f32x4 a = *(const f32x4*)(src + i * 16) * sc, b = *(const f32x4*)(src + i * 16 + 4) * sc, c = *(const f32x4*)(src + i * 16 + 8) * sc, d = *(const f32x4*)(src + i * 16 + 12) * sc;
        u32x4 w; w.x = pack4_fp8(a[0], a[1], a[2], a[3]); w.y = pack4_fp8(b[0], b[1], b[2], b[3]); w.z = pack4_fp8(c[0], c[1], c[2], c[3]); w.w = pack4_fp8(d[0], d[1], d[2], d[3]);
        *(u32x4*)(dst + (((l * 8 + (ch >> 3)) * 16384 + e) * 128 + (ch & 7) * 16)) = w;
    }
}

constexpr float PEER_SQU = 677.f;
__device__ __forceinline__ unsigned pack4_i8(float a, float b, float c, float d) {
    const int qa = (int)__builtin_rintf(__builtin_fminf(__builtin_fmaxf(a, -127.f), 127.f)), qb = (int)__builtin_rintf(__builtin_fminf(__builtin_fmaxf(b, -127.f), 127.f));
    const int qc = (int)__builtin_rintf(__builtin_fminf(__builtin_fmaxf(c, -127.f), 127.f)), qd = (int)__builtin_rintf(__builtin_fminf(__builtin_fmaxf(d, -127.f), 127.f));
    return (unsigned)(qa & 255) | ((unsigned)(qb & 255) << 8) | ((unsigned)(qc & 255) << 16) | ((unsigned)(qd & 255) << 24);
}
__device__ __forceinline__ void cvt_sliced_i8(const float* src, unsigned char* dst, float sc, size_t gtid, size_t gthreads) {
    for (size_t i = gtid; i < (size_t)NLAYER * 16384 * 64; i += gthreads) {
        const size_t le = i >> 6, ch = i & 63, l = le >> 14, e = le & 16383;
        const f32x4 a = *(const f32x4*)(src + i * 16) * sc, b = *(const f32x4*)(src + i * 16 + 4) * sc, c = *(const f32x4*)(src + i * 16 + 8) * sc, d = *(const f32x4*)(src + i * 16 + 12) * sc;
        u32x4 w; w.x = pack4_i8(a[0], a[1], a[2], a[3]); w.y = pack4_i8(b[0], b[1], b[2], b[3]); w.z = pack4_i8(c[0], c[1], c[2], c[3]); w.w = pack4_i8(d[0], d[1], d[2], d[3]);
        *(u32x4*)(dst + (((l * 8 + (ch >> 3)) * 16384 + e) * 128 + (ch & 7) * 16)) = w;
    }
}

#define DPP_MAX(v, ctrl) __builtin_fmaxf((v), __int_as_float(__builtin_amdgcn_update_dpp(0, __float_as_int(v), (ctrl), 0xF, 0xF, true)))
__device__ __forceinline__ float wave_max(float v) {
    v = DPP_MAX(v, 0xB1); v = DPP_MAX(v, 0x4E); v = DPP_MAX(v, 0x141); v = DPP_MAX(v, 0x140);
    v = __builtin_fmaxf(v, __int_as_float(__builtin_amdgcn_ds_swizzle(__float_as_int(v), 0x401F)));
    auto rr = __builtin_amdgcn_permlane32_swap(__float_as_uint(v), __float_as_uint(v), false, false); return __builtin_fmaxf(__uint_as_float(rr[0]), __uint_as_float(rr[1]));
}
__device__ __forceinline__ f32x4 ld4_x(const float* Xf, const bf16_t* Xb, size_t off) {
    if (Xf) return *(const f32x4*)(Xf + off);
    const u32x2 w = *(const u32x2*)(Xb + off); return (f32x4){bf_lo(w.x), bf_hi(w.x), bf_lo(w.y), bf_hi(w.y)};
}
__device__ __forceinline__ void norm_mod_rows(const float* X, const bf16_t* Xb, const float* gain, const float* shift, const float* scale, bf16_t* H, unsigned char* HQ, float* HS, int gw, int ngw, int lane, unsigned char* H8 = nullptr) {
    f32x4 vn[4];
    if (gw < MTOK) {
#pragma unroll
        for (int j = 0; j < 4; ++j) vn[j] = ld4_x(X, Xb, (size_t)gw * DM + 256 * j + 4 * lane);
    }
    for (int t = gw; t < MTOK; t += ngw) {
        const int b = t >> 13;
        f32x4 v[4]; float s = 0.f;
#pragma unroll
        for (int j = 0; j < 4; ++j) { v[j] = vn[j]; s += (v[j].x * v[j].x + v[j].y * v[j].y) + (v[j].z * v[j].z + v[j].w * v[j].w); }
        { const int tn = (t + ngw < MTOK) ? t + ngw : t;
#pragma unroll
          for (int j = 0; j < 4; ++j) vn[j] = ld4_x(X, Xb, (size_t)tn * DM + 256 * j + 4 * lane); }
        const float rstd = rsqrtf(wave_sum(s) * (1.f / DM) + EPS);
        float am = 0.f;
#pragma unroll
        for (int j = 0; j < 4; ++j) { const int col = 256 * j + 4 * lane;
            const f32x4 g = *(const f32x4*)(gain + col), sh = *(const f32x4*)(shift + b * MODS + col), sc = *(const f32x4*)(scale + b * MODS + col);
            const f32x4 y = (v[j] * rstd * g) * (sc + 1.f) + sh; v[j] = y;
            am = __builtin_fmaxf(am, __builtin_fmaxf(__builtin_fmaxf(__builtin_fabsf(y.x), __builtin_fabsf(y.y)), __builtin_fmaxf(__builtin_fabsf(y.z), __builtin_fabsf(y.w))));
            if (H8) *(unsigned*)(H8 + (size_t)t * DM + col) = pack4_fp8(y.x, y.y, y.z, y.w);
            else { u32x2 o; o.x = cvtpk(y.x, y.y); o.y = cvtpk(y.z, y.w); *(u32x2*)(H + (size_t)t * DM + col) = o; } }
        if (HQ) {
            am = __builtin_fmaxf(wave_max(am), 1e-20f); const float inv = 127.f / am;
#pragma unroll
            for (int j = 0; j < 4; ++j) *(unsigned*)(HQ + (size_t)t * DM + 256 * j + 4 * lane) = pack4_i8(v[j].x * inv, v[j].y * inv, v[j].z * inv, v[j].w * inv);
            if (lane == 0) HS[t] = am * (1.f / 127.f);
        }
    }
}

__device__ __forceinline__ void wpp_item(int item, const float* WQf, const float* SKf, bf16_t* WPP, char* lds, int tid, int wave, int lane) {
    const int l = item >> 8, hp = (item >> 4) & 15, k0 = (item & 15) * 64;
    float* Bs = (float*)lds;
    float* As = Bs + 128 * 132;
    const float* bsrc = SKf + ((size_t)l * 16 + hp) * 128 * 128;
    for (int i = tid; i < 128 * 32; i += 512) { const int r = i >> 5, c4 = i & 31; *(f32x4*)(Bs + r * 132 + c4 * 4) = *(const f32x4*)(bsrc + r * 128 + c4 * 4); }
    const float* asrc = WQf + ((size_t)l * 1024 + k0) * 2048 + hp * 128;
    for (int i = tid; i < 64 * 32; i += 512) { const int r = i >> 5, c4 = i & 31; *(f32x4*)(As + r * 132 + c4 * 4) = *(const f32x4*)(asrc + (size_t)r * 2048 + c4 * 4); }
    __syncthreads();
    const int kq = tid & 15, keyq = tid >> 4;
    float acc[4][4];
#pragma unroll
    for (int i = 0; i < 4; ++i)
#pragma unroll
        for (int j = 0; j < 4; ++j) acc[i][j] = 0.f;
    const float* ap = As + (4 * kq) * 132; const float* bp = Bs + (4 * keyq) * 132;
#pragma unroll 2
    for (int d = 0; d < 128; d += 4) { f32x4 a[4], b[4];
#pragma unroll
        for (int i = 0; i < 4; ++i) { a[i] = *(const f32x4*)(ap + i * 132 + d); b[i] = *(const f32x4*)(bp + i * 132 + d); }
#pragma unroll
        for (int i = 0; i < 4; ++i)
#pragma unroll
            for (int j = 0; j < 4; ++j) acc[i][j] = fmaf(a[i][0], b[j][0], fmaf(a[i][1], b[j][1], fmaf(a[i][2], b[j][2], fmaf(a[i][3], b[j][3], acc[i][j])))); }
    bf16_t* op = WPP + ((size_t)l * 2048 + hp * 128 + 4 * keyq) * 1024 + k0 + 4 * kq;
#pragma unroll
    for (int j = 0; j < 4; ++j) { u32x2 o; o.x = cvtpk(acc[0][j], acc[1][j]); o.y = cvtpk(acc[2][j], acc[3][j]); *(u32x2*)(op + (size_t)j * 1024) = o; }
    __syncthreads();
}

__device__ __forceinline__ void rope4(float* x, const float* cs, const float* sn) {
    const f32x4 c = *(const f32x4*)cs, s = *(const f32x4*)sn;
#pragma unroll
    for (int p = 0; p < 4; ++p) { const float a = x[2 * p], b = x[2 * p + 1]; x[2 * p] = a * c[p] - b * s[p]; x[2 * p + 1] = a * s[p] + b * c[p]; }
}
__device__ __forceinline__ void tok_load(int t, int lane, const bf16_t* Z, u32x4& a0, u32x4& a1, u32x4& a2) {
    const bf16_t* zr = Z + (size_t)t * NZ; const int l3 = lane < 20 ? lane : 0;
    a0 = *(const u32x4*)(zr + ZC_QB + 8 * lane); a1 = *(const u32x4*)(zr + ZC_KB + 8 * lane); a2 = *(const u32x4*)(zr + ZC_CKV + 8 * l3);
}
__device__ __forceinline__ void tok_prep(int t, int lane, u32x4 a0, u32x4 a1, u32x4 a2, const float* qg, const float* kg, const float* cqg, const float* ckvg,
                                         const float* cosB, const float* sinB, const float* cosC, const float* sinC,
                                         bf16_t* QB, bf16_t* KB, bf16_t* VB, bf16_t* CQN, bf16_t* CKVN, bf16_t* KC) {
    const int pos = t & (SEQ - 1);
    const int d0 = (lane & 7) * 8, i0 = (lane & 7) * 4;
    float x[8];
    {
        const u32x4 a = a0; unpack8(a, x);
        float ss = 0.f;
#pragma unroll
        for (int j = 0; j < 8; ++j) ss += x[j] * x[j];
        ss = sum8(ss);
        const float rstd = rsqrtf(ss * (1.f / 64.f) + EPS);
#pragma unroll
        for (int j = 0; j < 8; ++j) x[j] = x[j] * (rstd * (0.125f * 1.4426950408889634f)) * qg[d0 + j];
        rope4(x, cosB + pos * 32 + i0, sinB + pos * 32 + i0);
        *(u32x4*)(QB + (size_t)t * 512 + 8 * lane) = pack8f(x);
    }
    {
        const u32x4 a = a1; unpack8(a, x);
        float ss = 0.f;
#pragma unroll
        for (int j = 0; j < 8; ++j) ss += x[j] * x[j];
        ss = sum8(ss);
        float s32 = DPP_ADD(ss, 0x140); s32 = xor16_add(s32);
        if (lane < 16) {
            const float rstd = rsqrtf(ss * (1.f / 64.f) + EPS);
#pragma unroll
            for (int j = 0; j < 8; ++j) x[j] = x[j] * rstd * kg[d0 + j];
            rope4(x, cosB + pos * 32 + i0, sinB + pos * 32 + i0);
            *(u32x4*)(KB + (size_t)t * 128 + 8 * lane) = pack8f(x);
        } else if (lane < 32) {
            *(u32x4*)(VB + (size_t)t * 128 + 8 * (lane - 16)) = a;
        } else {
            const float rstd = rsqrtf(s32 * (1.f / 256.f) + EPS);
            const int c0 = 8 * (lane - 32);
#pragma unroll
            for (int j = 0; j < 8; ++j) x[j] = x[j] * rstd * cqg[c0 + j];
            *(u32x4*)(CQN + (size_t)t * 256 + c0) = pack8f(x);
        }
    }
    {
        const u32x4 a = a2; unpack8(a, x);
        float ss = 0.f;
#pragma unroll
        for (int j = 0; j < 8; ++j) ss += x[j] * x[j];
        ss = sum16(ss);
        if (lane < 16) {
            const float rstd = rsqrtf(ss * (1.f / 128.f) + EPS);
#pragma unroll
            for (int j = 0; j < 8; ++j) x[j] = x[j] * rstd * ckvg[8 * lane + j];
            *(u32x4*)(CKVN + (size_t)t * 128 + 8 * lane) = pack8f(x);
        } else if (lane < 20) {
            const int j0 = (lane - 16) * 4;
            rope4(x, cosC + pos * 16 + j0, sinC + pos * 16 + j0);
            const u32x4 w = pack8f(x);
#pragma unroll
            for (int h = 0; h < 8; ++h) *(u32x4*)(KC + (size_t)t * 768 + h * 96 + 64 + 8 * (lane - 16)) = w;
        }
    }
}

__device__ __forceinline__ void sgu_item(int item, const bf16_t* Z, const float* vgain, const bf16_t* WS, const float* bs, bf16_t* YA, char* lds, int tid, int wave, int lane) {
    const int c = item >> 1, hh = item & 1, t0 = c * 128;
    float* rs = (float*)lds; char* vT = lds + 1024;
    {
        const int tt = tid >> 2, part = tid & 3; const bf16_t* zp = Z + (size_t)(t0 + tt) * NZ + ZC_V + part * 128; float ss = 0.f;
#pragma unroll
        for (int i = 0; i < 16; ++i) { const u32x4 w = *(const u32x4*)(zp + i * 8); float x[8]; unpack8(w, x);
#pragma unroll
            for (int j = 0; j < 8; ++j) ss += x[j] * x[j]; }
        ss = sum4(ss);
        if (part == 0) rs[tt] = rsqrtf(ss * (1.f / 512.f) + EPS);
    }
    __syncthreads();
    const int r32 = lane & 31, hi = lane >> 5, wp = wave >> 1, wd = wave & 1;
    for (int gi = 0; gi < 4; ++gi) {
        const int g = hh * 4 + gi;
        {
            const int q = tid >> 2, cb = (tid & 3) * 16; const bf16_t* zp = Z + (size_t)(t0 + q) * NZ + ZC_V + g * 64 + cb; const float r = rs[q];
            const u32x4 w0 = *(const u32x4*)zp, w1 = *(const u32x4*)(zp + 8);
            float v[16]; unpack8(w0, v); unpack8(w1, v + 8);
            const float* gp = vgain + g * 64 + cb;
#pragma unroll
            for (int j = 0; j < 16; ++j) *(unsigned short*)(vT + (cb + j) * 272 + q * 2) = f2bf(v[j] * r * gp[j]);
        }
        __syncthreads();
        f32x16 acc = {};
        const bf16_t* wa = WS + ((size_t)g * 128 + wp * 32 + r32) * 128 + hi * 8;
        const char* vb = vT + (wd * 32 + r32) * 272 + hi * 16;
#pragma unroll
        for (int ks = 0; ks < 8; ++ks) {
            const bf16x8 a = *(const bf16x8*)(wa + ks * 16), b = *(const bf16x8*)(vb + ks * 32);
            acc = __builtin_amdgcn_mfma_f32_32x32x16_bf16(b, a, acc, 0, 0, 0);
        }
        { const int p = wp * 32 + r32, t = t0 + p; const float bsv = bs[g * 128 + p];
#pragma unroll
          for (int g4 = 0; g4 < 4; ++g4) { const int ch0 = g * 64 + wd * 32 + 8 * g4 + 4 * hi;
            const u32x2 uu = *(const u32x2*)(Z + (size_t)t * NZ + ZC_U + ch0);
            *(unsigned*)((unsigned char*)YA + (size_t)t * 1536 + ch0) = pack4_fp8(bf_lo(uu.x) * (acc[4 * g4] + bsv), bf_hi(uu.x) * (acc[4 * g4 + 1] + bsv), bf_lo(uu.y) * (acc[4 * g4 + 2] + bsv), bf_hi(uu.y) * (acc[4 * g4 + 3] + bsv)); } }
        __syncthreads();
    }
}

__device__ __forceinline__ int fkey(float v) { const int u = __float_as_int(v); return u ^ ((u >> 31) & 0x7fffffff); }
__device__ __forceinline__ float fval(int k) { return __int_as_float(k ^ ((k >> 31) & 0x7fffffff)); }
#define CE_DESC(a, b) do { const int t_ = max(a, b); b = min(a, b); a = t_; } while (0)
#define CE_ASC(a, b) do { const int t_ = min(a, b); b = max(a, b); a = t_; } while (0)
__device__ __forceinline__ void sort16_desc(int* x) {
#pragma unroll
    for (int k = 2; k <= 16; k <<= 1)
#pragma unroll
        for (int j = k >> 1; j > 0; j >>= 1)
#pragma unroll
            for (int i = 0; i < 16; ++i) { const int l = i ^ j; if (l > i) { if ((i & k) == 0) CE_DESC(x[i], x[l]); else CE_ASC(x[i], x[l]); } }
}
__device__ __forceinline__ void merge16_desc(int* a, const int* b) {
#pragma unroll
    for (int i = 0; i < 16; ++i) a[i] = max(a[i], b[15 - i]);
#pragma unroll
    for (int j = 8; j > 0; j >>= 1)
#pragma unroll
        for (int i = 0; i < 16; ++i) { const int l = i ^ j; if (l > i) CE_DESC(a[i], a[l]); }
}
__device__ __forceinline__ void quad_merge16(int* a) {
    int b[16];
#pragma unroll
    for (int i = 0; i < 16; ++i) b[i] = __builtin_amdgcn_update_dpp(0, a[i], 0xB1, 0xF, 0xF, true);
    merge16_desc(a, b);
#pragma unroll
    for (int i = 0; i < 16; ++i) b[i] = __builtin_amdgcn_update_dpp(0, a[i], 0x4E, 0xF, 0xF, true);
    merge16_desc(a, b);
}
__device__ const unsigned char PEER_CAND[52] = {
    0,1,2,3,4,5,6,7,8,9,10,11,12,13,14,15, 16,17,18,19,20,21,22,23, 32,33,34,35,36, 48,49,50,51, 64,65,66, 80,81, 96,97, 112,113, 128, 144, 160, 176, 192, 208, 224, 240, 0, 0};
constexpr int SC_RS = 133;
__device__ __forceinline__ void peer_topk_sload(int item, const bf16_t* SCO, u32x4 (&sreg)[4], int tid) {
    const int tile = item >> 3, h = item & 7, t0 = tile * 64, row = tid >> 2, part = tid & 3, p = row >> 6, token = row & 63;
    const bf16_t* sp = SCO + (size_t)(t0 + token) * 2048 + h * 256 + p * 128 + part * 32;
#pragma unroll
    for (int i = 0; i < 4; ++i) sreg[i] = *(const u32x4*)(sp + 8 * i);
}
__device__ __forceinline__ void peer_topk_item(int item, int item_next, const bf16_t* SCO, int* IDS, float* GW, char* lds, u32x4 (&sreg)[4], int tid, int wave, int lane) {
    const int tile = item >> 3, h = item & 7, t0 = tile * 64;
    int* tk = (int*)lds;
    {
        const int row = tid >> 2, part = tid & 3;
        float sv[32]; unpack8(sreg[0], sv); unpack8(sreg[1], sv + 8); unpack8(sreg[2], sv + 16); unpack8(sreg[3], sv + 24);
        if (item_next < 2048) peer_topk_sload(item_next, SCO, sreg, tid);
        int x[16], y[16];
#pragma unroll
        for (int e = 0; e < 16; ++e) { x[e] = (fkey(sv[e]) & ~127) | (part * 32 + e); y[e] = (fkey(sv[16 + e]) & ~127) | (part * 32 + 16 + e); }
        sort16_desc(x); sort16_desc(y); merge16_desc(x, y);
        quad_merge16(x);
        if (part == 0) {
#pragma unroll
            for (int q = 0; q < 4; ++q) *(u32x4*)(tk + row * 16 + 4 * q) = (u32x4){(unsigned)x[4 * q], (unsigned)x[4 * q + 1], (unsigned)x[4 * q + 2], (unsigned)x[4 * q + 3]};
        }
    }
    __syncthreads();
    if (tid < 256) {
        const int token = tid >> 2, q = tid & 3;
        const int* ta = tk + token * 16; const int* tb = tk + (64 + token) * 16;
        int x[16];
#pragma unroll
        for (int k = 0; k < 13; ++k) { const int c = 4 * k + q; const int ij = PEER_CAND[c];
            const float s = fval(ta[ij >> 4] & ~127) + fval(tb[ij & 15] & ~127);
            x[k] = (c < 50) ? ((fkey(s) & ~255) | ij) : (int)0x80000000; }
        x[13] = x[14] = x[15] = (int)0x80000000;
        sort16_desc(x);
        quad_merge16(x);
        int mine[4];
#pragma unroll
        for (int m = 0; m < 4; ++m) mine[m] = (q == 0) ? x[m] : (q == 1) ? x[4 + m] : (q == 2) ? x[8 + m] : x[12 + m];
        const int p0 = x[0] & 255; const float vmax = fval(ta[p0 >> 4] & ~127) + fval(tb[p0 & 15] & ~127);
        float ev[4]; int id[4]; float sum = 0.f;
#pragma unroll
        for (int m = 0; m < 4; ++m) { const int pos = mine[m] & 255, ka = ta[pos >> 4], kb2 = tb[pos & 15];
            const float v = fval(ka & ~127) + fval(kb2 & ~127); id[m] = (ka & 127) * 128 + (kb2 & 127);
            ev[m] = __builtin_amdgcn_exp2f((v - vmax) * 1.4426950408889634f); sum += ev[m]; }
        sum = sum4(sum);
        const float inv = 1.f / sum;
        *(u32x4*)(IDS + (size_t)(t0 + token) * 128 + h * 16 + 4 * q) = (u32x4){(unsigned)id[0], (unsigned)id[1], (unsigned)id[2], (unsigned)id[3]};
        *(f32x4*)(GW + (size_t)(t0 + token) * 128 + h * 16 + 4 * q) = (f32x4){ev[0] * inv, ev[1] * inv, ev[2] * inv, ev[3] * inv};
    }
    __syncthreads();
}

__device__ __forceinline__ float dot8_unused(u32x4 a, const float* h, float acc) {
    acc = fmaf(bf_lo(a.x), h[0], acc); acc = fmaf(bf_hi(a.x), h[1], acc); acc = fmaf(bf_lo(a.y), h[2], acc); acc = fmaf(bf_hi(a.y), h[3], acc);
    acc = fmaf(bf_lo(a.z), h[4], acc); acc = fmaf(bf_hi(a.z), h[5], acc); acc = fmaf(bf_lo(a.w), h[6], acc); acc = fmaf(bf_hi(a.w), h[7], acc);
    return acc;
}
#define DPP_IADD(v, ctrl) ((v) + __builtin_amdgcn_update_dpp(0, (v), (ctrl), 0xF, 0xF, true))
__device__ __forceinline__ void peer_u_pass(int s, int t0, int tstep, int lane, const unsigned char* HQ, const float* HS, const unsigned char* PUs, const int* IDS, bf16_t* SPs) {
    const int sub = lane >> 3, c = lane & 7;
    if (t0 >= MTOK) return;
    const int tlast = t0 + ((MTOK - 1 - t0) / tstep) * tstep;
    u32x4 idc[4], idn[4]; u32x4 hn, hc; float hsn, hsc; u32x4 rA[8], rB[8]; float p[16];
#define U_LDI(tt) do { const int t_ = (tt) < tlast ? (tt) : tlast; _Pragma("unroll") for (int q = 0; q < 4; ++q) idn[q] = *(const u32x4*)(IDS + (size_t)t_ * 128 + sub * 16 + 4 * q); \
        hn = *(const u32x4*)(HQ + (size_t)t_ * DM + s * 128 + c * 16); hsn = HS[t_]; } while (0)
#define U_ISSUE(R, ID, K0) do { _Pragma("unroll") for (int k = 0; k < 8; ++k) R[k] = *(const u32x4*)(PUs + (size_t)ID[((K0) + k) >> 2][((K0) + k) & 3] * 128 + c * 16); } while (0)
#define U_COMP(R, K0) do { _Pragma("unroll") for (int k = 0; k < 8; ++k) { int a = 0; _Pragma("unroll") for (int q = 0; q < 4; ++q) a = __builtin_amdgcn_sdot4((int)R[k][q], (int)hc[q], a, false); \
            a = DPP_IADD(a, 0xB1); a = DPP_IADD(a, 0x4E); a = DPP_IADD(a, 0x141); p[(K0) + k] = (float)a * hsc; } } while (0)
    U_LDI(t0);
#pragma unroll
    for (int q = 0; q < 4; ++q) idc[q] = idn[q];
    hc = hn; hsc = hsn * (1.f / PEER_SQU);
    U_ISSUE(rA, idc, 0); U_LDI(t0 + tstep);
    for (int t = t0; t <= tlast; t += tstep) {
        U_ISSUE(rB, idc, 8);
        U_COMP(rA, 0);
        U_ISSUE(rA, idn, 0);
        U_COMP(rB, 8);
        if (c == 0) { bf16_t* o = SPs + (size_t)t * 128 + sub * 16;
            *(u32x4*)o = pack8f(p); *(u32x4*)(o + 8) = pack8f(p + 8); }
#pragma unroll
        for (int q = 0; q < 4; ++q) idc[q] = idn[q];
        hc = hn; hsc = hsn * (1.f / PEER_SQU);
        U_LDI(t + 2 * tstep);
    }
#undef U_LDI
#undef U_ISSUE
#undef U_COMP
}
constexpr float PEER_SQV = 42.333f;
__device__ __forceinline__ void peer_v_pass(int s, int t0, int tstep, int lane, const unsigned char* PVs, const int* IDS, const unsigned* WQ, const float* WSC, bf16_t* X, const float* g2) {
    const int sub = lane >> 3, c = lane & 7;
    if (t0 >= MTOK) return;
    const int tlast = t0 + ((MTOK - 1 - t0) / tstep) * tstep;
    u32x4 idc[4], idn[4]; u32x4 wc, wn; float wsc_c, wsc_n; u32x4 rA[8], rB[8]; int acc[16];
#define V_LDI(tt) do { const int t_ = (tt) < tlast ? (tt) : tlast; _Pragma("unroll") for (int q = 0; q < 4; ++q) idn[q] = *(const u32x4*)(IDS + (size_t)t_ * 128 + sub * 16 + 4 * q); \
        wn = *(const u32x4*)(WQ + (size_t)t_ * 32 + sub * 4); wsc_n = WSC[t_]; } while (0)
#define V_ISSUE(R, ID, K0) do { _Pragma("unroll") for (int k = 0; k < 8; ++k) R[k] = *(const u32x4*)(PVs + (size_t)ID[((K0) + k) >> 2][((K0) + k) & 3] * 128 + c * 16); } while (0)
#define V_ACC(R, G0) do { _Pragma("unroll") for (int g = 0; g < 2; ++g) { const int wq_ = (int)wc[(G0) + g]; _Pragma("unroll") for (int Q = 0; Q < 4; ++Q) { \
            const unsigned m0 = R[4 * g][Q], m1 = R[4 * g + 1][Q], m2 = R[4 * g + 2][Q], m3 = R[4 * g + 3][Q]; \
            const unsigned a01l = __builtin_amdgcn_perm(m1, m0, 0x05010400u), a01h = __builtin_amdgcn_perm(m1, m0, 0x07030602u); \
            const unsigned a23l = __builtin_amdgcn_perm(m3, m2, 0x05010400u), a23h = __builtin_amdgcn_perm(m3, m2, 0x07030602u); \
            acc[4 * Q + 0] = __builtin_amdgcn_sdot4((int)__builtin_amdgcn_perm(a23l, a01l, 0x05040100u), wq_, acc[4 * Q + 0], false); \
            acc[4 * Q + 1] = __builtin_amdgcn_sdot4((int)__builtin_amdgcn_perm(a23l, a01l, 0x07060302u), wq_, acc[4 * Q + 1], false); \
            acc[4 * Q + 2] = __builtin_amdgcn_sdot4((int)__builtin_amdgcn_perm(a23h, a01h, 0x05040100u), wq_, acc[4 * Q + 2], false); \
            acc[4 * Q + 3] = __builtin_amdgcn_sdot4((int)__builtin_amdgcn_perm(a23h, a01h, 0x07060302u), wq_, acc[4 * Q + 3], false); } } } while (0)
    V_LDI(t0);
#pragma unroll
    for (int q = 0; q < 4; ++q) idc[q] = idn[q];
    wc = wn; wsc_c = wsc_n;
    V_ISSUE(rA, idc, 0); V_LDI(t0 + tstep);
    for (int t = t0; t <= tlast; t += tstep) {
        V_ISSUE(rB, idc, 8);
#pragma unroll
        for (int j = 0; j < 16; ++j) acc[j] = 0;
        V_ACC(rA, 0);
        V_ISSUE(rA, idn, 0);
        V_ACC(rB, 2);
        float accf[16];
#pragma unroll
        for (int j = 0; j < 16; ++j) { int a = DPP_IADD(acc[j], 0x128); a += __builtin_amdgcn_ds_swizzle(a, 0x401F);
            auto rr = __builtin_amdgcn_permlane32_swap((unsigned)a, (unsigned)a, false, false); a = (int)rr[0] + (int)rr[1]; accf[j] = (float)a * wsc_c; }
        if (sub == 0) { const int b = t >> 13, col = s * 128 + c * 16; bf16_t* xp = X + (size_t)t * DM + col; const float* gp = g2 + b * MODS + col;
            float xv[16]; unpack8(*(const u32x4*)xp, xv); unpack8(*(const u32x4*)(xp + 8), xv + 8);
#pragma unroll
            for (int q = 0; q < 4; ++q) { const f32x4 g0 = *(const f32x4*)(gp + 4 * q);
#pragma unroll
                for (int j = 0; j < 4; ++j) xv[4 * q + j] += g0[j] * accf[4 * q + j]; }
            *(u32x4*)xp = pack8f(xv); *(u32x4*)(xp + 8) = pack8f(xv + 8); }
#pragma unroll
        for (int q = 0; q < 4; ++q) idc[q] = idn[q];
        wc = wn; wsc_c = wsc_n;
        V_LDI(t + 2 * tstep);
    }
#undef V_LDI
#undef V_ISSUE
#undef V_ACC
}
__device__ __forceinline__ void final_norm_rows(const bf16_t* X, const float* gain, float* out, int gw, int ngw, int lane) {
    for (int t = gw; t < MTOK; t += ngw) {
        f32x4 v[4]; float s = 0.f;
#pragma unroll
        for (int j = 0; j < 4; ++j) { v[j] = ld4_x(nullptr, X, (size_t)t * DM + 256 * j + 4 * lane); s += (v[j].x * v[j].x + v[j].y * v[j].y) + (v[j].z * v[j].z + v[j].w * v[j].w); }
        const float rstd = rsqrtf(wave_sum(s) * (1.f / DM) + EPS);
#pragma unroll
        for (int j = 0; j < 4; ++j) { const int col = 256 * j + 4 * lane; const f32x4 g = *(const f32x4*)(gain + col);
            *(f32x4*)(out + (size_t)t * DM + col) = v[j] * rstd * g; }
    }
}
#ifndef MK_SPLIT
#define MK_SPLIT 0
#endif
constexpr int PPL = 13;
constexpr int N_PHASES = 2 + PPL * NLAYER;
struct Args { const float* in[25]; float* out; unsigned char* ws; int ph_lo, ph_hi; };
static_assert(sizeof(Args) == 25 * 8 + 8 + 8 + 8, "Args has no padding");

__global__ void __launch_bounds__(NWAVES * 64, 2) fwd(Args args) {
    extern __shared__ __attribute__((aligned(16))) unsigned char lds[];
    const int tid = threadIdx.x, lane = tid & 63, wave = __builtin_amdgcn_readfirstlane(tid >> 6);
    const int G = gridDim.x, bx = blockIdx.x;
    const int vcu = (G % 8 == 0) ? (bx % 8) * (G / 8) + bx / 8 : bx;
    const int gw = vcu * NWAVES + wave, NGW = G * NWAVES;
    unsigned* ctl = (unsigned*)(args.ws + WS_CTL);
    volatile LAS unsigned* MISC = (volatile LAS unsigned*)((LAS unsigned char*)lds + MISC_OFF);
    for (int u = tid; u < (LDS_BYTES - MISC_OFF) / 4; u += NWAVES * 64) ((LAS unsigned*)((LAS unsigned char*)lds + MISC_OFF))[u] = 0u;
    __syncthreads();
    XcdBarrier bar = xcd_barrier_post(ctl + CW_BAR, MISC + 8);
    const int lo = args.ph_lo, hi = args.ph_hi;
#define IN(k) (lo <= (k) && (k) < hi)
#ifndef PHASE_MASK
#define PHASE_MASK 0x7FFF
#endif
#define EN(i) ((PHASE_MASK >> (i)) & 1)
#ifndef SUB_MASK
#define SUB_MASK 0x1F
#endif
#define SUB(i) ((SUB_MASK >> (i)) & 1)
#ifndef PROBE_PHASE
#define PROBE_PHASE -1
#endif
#ifndef PROBE_N
#define PROBE_N 2
#endif
#define REPS(i) for (int rep_ = 0; rep_ < ((PROBE_PHASE == (i)) ? PROBE_N : 1); ++rep_)
#define SEAM(k) do { if (IN(k) && IN((k) + 1)) { xcd_barrier(bar); if (PROBE_PHASE == 99) xcd_barrier(bar); } } while (0)

    typedef const unsigned char __attribute__((address_space(4)))* kptr_t;
#define PH_BEGIN int tid = threadIdx.x; asm volatile("" : "+v"(tid)); const int lane = tid & 63, wave = __builtin_amdgcn_readfirstlane(tid >> 6), gw = vcu * NWAVES + wave; kptr_t kp = (kptr_t)__builtin_amdgcn_kernarg_segment_ptr(); asm volatile("" : "+s"(kp)); unsigned char* ws = *(unsigned char* const __attribute__((address_space(4)))*)(kp + 208);
#define INP(i) (*(const float* const __attribute__((address_space(4)))*)(kp + 8 * (i)))
#define WSP(T, off) ((T*)(ws + (off)))
#define x_in INP(0)
#define c_in INP(1)
#define w_ada INP(2)
#define b_ada INP(3)
#define norm1_gain INP(4)
#define w_in INP(5)
#define a_v_gain INP(6)
#define a_w_s INP(7)
#define a_b_s INP(8)
#define b_q_gain INP(9)
#define b_k_gain INP(10)
#define c_q_gain INP(11)
#define c_w_uq INP(12)
#define c_kv_gain INP(13)
#define c_w_ukv INP(14)
#define w_pa INP(15)
#define w_pb INP(16)
#define w_pc INP(17)
#define w_out INP(18)
#define norm2_gain INP(19)
#define peer_wq INP(20)
#define peer_sk INP(21)
#define peer_u INP(22)
#define peer_v INP(23)
#define final_gain INP(24)
#define MOD WSP(float, WS_MOD)
#define WIN WSP(bf16_t, WS_WIN)
#define WUQ WSP(bf16_t, WS_WUQ)
#define WUKV WSP(bf16_t, WS_WUKV)
#define WP WSP(bf16_t, WS_WP)
#define WOUT WSP(bf16_t, WS_WOUT)
#define WQ WSP(bf16_t, WS_WQ)
#define SUBK WSP(bf16_t, WS_SUBK)
#define WSS WSP(bf16_t, WS_WSS)
#define cosB WSP(float, WS_ROPE)
#define sinB WSP(float, WS_ROPE + SEQ * 32 * 4)
#define cosC WSP(float, WS_ROPE + SEQ * 64 * 4)
#define sinC WSP(float, WS_ROPE + SEQ * 80 * 4)
#define PU WSP(bf16_t, WS_PU)
#define PVt WSP(bf16_t, WS_PV)
#define X WSP(bf16_t, WS_X)
#define H WSP(bf16_t, WS_H)
#define Z WSP(bf16_t, WS_Z)
#define YA WSP(bf16_t, WS_YA)
#define YB (WSP(bf16_t, WS_YA) + 512)
#define YC (WSP(bf16_t, WS_YA) + 1024)
#define QB WSP(bf16_t, WS_QB)
#define KB WSP(bf16_t, WS_KB)
#define VB WSP(bf16_t, WS_VB)
#define CQN WSP(bf16_t, WS_CQN)
#define CKVN WSP(bf16_t, WS_CKVN)
#define QC WSP(bf16_t, WS_QC)
#define KC WSP(bf16_t, WS_KC)
#define VC WSP(bf16_t, WS_VC)
#define MF WSP(float, WS_MF)
#define MB WSP(bf16_t, WS_MB)
#define QP WSP(bf16_t, WS_QP)
#define IDS WSP(int, WS_IDS)
#define GW WSP(float, WS_GW)

    if (EN(0) && IN(0)) REPS(0) { PH_BEGIN
        const size_t gtid = (size_t)bx * (NWAVES * 64) + tid, gthreads = (size_t)G * NWAVES * 64;
        if (bx & 1) for (int it = bx; it < NLAYER * 256; it += G) wpp_item(it, peer_wq, peer_sk, WQ, (char*)lds, tid, wave, lane);
        {
            LAS float* scr = (LAS float*)((LAS unsigned char*)lds + wave * 8704);
            constexpr int I_IN = 16 * 165, I_UQ = 4 * 24, I_UKV = 2 * 32, I_P = 8 * 32, I_OUT = 16 * 32;
            constexpr int PER_L = I_IN + I_UQ + I_UKV + 3 * I_P + I_OUT;
            for (int it = gw; it < NLAYER * PER_L; it += NGW) {
                const int l = it / PER_L; int r = it % PER_L;
                const float* W; int K, N, ldw; bf16_t* WT; float f8 = 0.f;
                if (r < I_IN) { W = w_in + (size_t)l * 1024 * 5280; K = 1024; N = 5280; ldw = 1024; WT = (bf16_t*)((unsigned char*)WIN + (size_t)l * NZ * 1024); f8 = 32.f; }
                else if ((r -= I_IN) < I_UQ) { W = c_w_uq + (size_t)l * 256 * 768; K = 256; N = 768; ldw = 256; WT = WUQ + (size_t)l * 768 * 256; }
                else if ((r -= I_UQ) < I_UKV) { W = c_w_ukv + (size_t)l * 128 * 1024; K = 128; N = 1024; ldw = 128; WT = WUKV + (size_t)l * 1024 * 128; }
                else if ((r -= I_UKV) < I_P) { W = w_pa + (size_t)l * 512 * 1024; K = 512; N = 1024; ldw = 1536; WT = (bf16_t*)((unsigned char*)WP + (size_t)l * 1024 * 1536 + 0); f8 = 32.f; }
                else if ((r -= I_P) < I_P) { W = w_pb + (size_t)l * 512 * 1024; K = 512; N = 1024; ldw = 1536; WT = (bf16_t*)((unsigned char*)WP + (size_t)l * 1024 * 1536 + 512); f8 = 32.f; }
                else if ((r -= I_P) < I_P) { W = w_pc + (size_t)l * 512 * 1024; K = 512; N = 1024; ldw = 1536; WT = (bf16_t*)((unsigned char*)WP + (size_t)l * 1024 * 1536 + 1024); f8 = 32.f; }
                else { r -= I_P; W = w_out + (size_t)l * 1024 * 1024; K = 1024; N = 1024; ldw = 1024; WT = (bf16_t*)((unsigned char*)WOUT + (size_t)l * 1024 * 1024); f8 = 32.f; }
                p0_transpose_item(W, K, N, WT, ldw, scr, r, lane, f8);
            }
        }
        for (size_t i = gtid; i < (size_t)NLAYER * 96 * 64; i += gthreads) { const size_t l = i / (96 * 64), r = i % (96 * 64);
            *(u32x4*)((unsigned char*)WIN + (l * NZ + 5280) * 1024 + r * 16) = (u32x4){0u, 0u, 0u, 0u}; }
        cvt_flat(a_w_s, WSS, (size_t)NLAYER * 8 * 128 * 128 / 8, gtid, gthreads);
        cvt_sliced_i8(peer_u, (unsigned char*)PU, PEER_SQU, gtid, gthreads);
        cvt_sliced_i8(peer_v, (unsigned char*)PVt, PEER_SQV, gtid, gthreads);
        for (size_t i = gtid; i < (size_t)SEQ * 48; i += gthreads) {
            const int pos = (int)(i / 48), e = (int)(i % 48); const float row = (float)(pos >> 6), col = (float)(pos & 63);
            float ang; if (e < 32) { const int k = e & 15; const float f = __builtin_amdgcn_exp2f(-(float)(2 * k) * (13.287712379549449f / 32.f)); ang = ((e < 16) ? row : col) * f; }
            else { const int e2 = e - 32, k = e2 & 7; const float f = __builtin_amdgcn_exp2f(-(float)(2 * k) * (13.287712379549449f / 16.f)); ang = ((e2 < 8) ? row : col) * f; }
            float rev = ang * 0.15915494309189535f; rev -= floorf(rev);
            const float cv = __builtin_amdgcn_cosf(rev), sv = __builtin_amdgcn_sinf(rev);
            if (e < 32) { cosB[pos * 32 + e] = cv; sinB[pos * 32 + e] = sv; } else { cosC[pos * 16 + e - 32] = cv; sinC[pos * 16 + e - 32] = sv; }
        }
        __syncthreads();
        for (int it = bx; it < NLAYER * 96; it += G) {
            const int l = it / 96, nc = it % 96, n = nc * 64 + lane, k0 = wave * 128;
            const float* wp = w_ada + ((size_t)l * 1024 + k0) * MODS + n;
            float a0 = 0.f, a1 = 0.f;
#pragma unroll 8
            for (int k = 0; k < 128; ++k) { const float w = wp[(size_t)k * MODS]; const float c0 = c_in[k0 + k], c1 = c_in[1024 + k0 + k];
                a0 = fmaf(c0 * sigmoidf_(c0), w, a0); a1 = fmaf(c1 * sigmoidf_(c1), w, a1); }
            float* part = (float*)lds;
            part[(0 * 8 + wave) * 64 + lane] = a0; part[(1 * 8 + wave) * 64 + lane] = a1;
            __syncthreads();
            if (tid < 128) { const int b = tid >> 6; float sum = b_ada[l * MODS + nc * 64 + lane];
#pragma unroll
                for (int kg = 0; kg < 8; ++kg) sum += part[(b * 8 + kg) * 64 + lane];
                MOD[((size_t)l * 2 + b) * MODS + nc * 64 + lane] = sum; }
            __syncthreads();
        }
        if (!(bx & 1)) for (int it = bx; it < NLAYER * 256; it += G) wpp_item(it, peer_wq, peer_sk, WQ, (char*)lds, tid, wave, lane);
    }
    SEAM(0);
    for (int l = 0; l < NLAYER; ++l) {
        const int pb = 1 + PPL * l;
#define MODL (MOD + (size_t)l * 2 * MODS)
        if (EN(1) && IN(pb + 0)) REPS(1) { PH_BEGIN norm_mod_rows(l == 0 ? x_in : (const float*)nullptr, X, norm1_gain + l * DM, MODL + 0, MODL + 1024, H, nullptr, nullptr, gw, NGW, lane, (unsigned char*)H); }
        SEAM(pb + 0);
        if (EN(2) && IN(pb + 1)) REPS(2) { PH_BEGIN
            pg8::Gemm g{H, (const bf16_t*)((const unsigned char*)WIN + (size_t)l * NZ * 1024), MTOK, NZ, 512}; pg8::StaticOrder S; S.init(MTOK, NZ, G, bx);
            pg8::EpiZ E{Z, WSP(unsigned char, WS_G8), 1.f / 32.f};
            pg8::gemm_phase<pg8::EpiZ, pg8::StaticOrder, true, true, true>((LAS unsigned char*)lds, g, S, E);
        }
        SEAM(pb + 1);
        if (EN(3) && IN(pb + 2)) REPS(3) { PH_BEGIN
            for (int it = vcu; it < 256; it += G)
                sgu_item(it, Z, a_v_gain + l * 512, WSS + (size_t)l * 8 * 128 * 128, a_b_s + l * 8 * 128, YA, (char*)lds, tid, wave, lane);
            { u32x4 n0, n1, n2; tok_load(gw < MTOK ? gw : 0, lane, Z, n0, n1, n2);
              for (int t = gw; t < MTOK; t += NGW) { const u32x4 c0 = n0, c1 = n1, c2 = n2;
                tok_load((t + NGW < MTOK) ? t + NGW : t, lane, Z, n0, n1, n2);
                tok_prep(t, lane, c0, c1, c2, b_q_gain + l * 64, b_k_gain + l * 64, c_q_gain + l * 256, c_kv_gain + l * 128, cosB, sinB, cosC, sinC, QB, KB, VB, CQN, CKVN, KC); } }
        }
        SEAM(pb + 2);
        if (EN(4) && IN(pb + 3)) REPS(4) {
            if (SUB(0)) { PH_BEGIN int Kq = 256; asm volatile("" : "+s"(Kq)); pg8::Gemm g{CQN, WUQ + (size_t)l * 768 * 256, MTOK, 768, Kq}; pg8::StaticOrder S; S.init(MTOK, 768, G, bx);
              pg8::EpiQC E{QC, cosC, sinC};
              pg8::gemm_phase<pg8::EpiQC, pg8::StaticOrder, true, true>((LAS unsigned char*)lds, g, S, E); }
            if (SUB(1)) { PH_BEGIN int Kk = 128; asm volatile("" : "+s"(Kk)); pg8::Gemm g{CKVN, WUKV + (size_t)l * 1024 * 128, MTOK, 1024, Kk}; pg8::StaticOrder S; S.init(MTOK, 1024, G, bx);
              pg8::EpiKV E{KC, VC};
              pg8::gemm_phase<pg8::EpiKV, pg8::StaticOrder, true, true>((LAS unsigned char*)lds, g, S, E); }
        }
        SEAM(pb + 3);
        if (EN(5) && IN(pb + 4)) REPS(5) { PH_BEGIN
            for (int u = vcu; u < 1024; u += G) for (int rep2_ = 0; rep2_ < ((PROBE_PHASE == 51 && (u >> 9) == 1) || (PROBE_PHASE == 52 && (u >> 9) == 0) ? 2 : 1); ++rep2_) {
                const int typ = u >> 9, idx = u & 511, bh = idx >> 5, qb = idx & 31, b = bh >> 3, h = bh & 7;
                const size_t r0 = (size_t)b * SEQ, q0 = r0 + (size_t)qb * 256;
#ifndef ONLY_TYP
#define ONLY_TYP -1
#endif
                if (typ == 0) { if (ONLY_TYP != 1) att96::attn_unit<8, 768, 768, 512, 1536>((const att96::bf16*)(QC + q0 * 768 + h * 96), (const att96::bf16*)(KC + r0 * 768 + h * 96), (const att96::bf16*)(VC + r0 * 512 + h * 64), (att96::bf16*)((unsigned char*)YA + q0 * 1536 + 1024 + h * 64), (char*)lds); }
                else { if (ONLY_TYP != 0) att64::attn_unit<8, 512, 128, 1536>((const att64::bf16*)(QB + q0 * 512 + h * 64), (const att64::bf16*)(KB + r0 * 128 + (h >> 2) * 64), (const att64::bf16*)(VB + r0 * 128 + (h >> 2) * 64), (att64::bf16*)((unsigned char*)YA + q0 * 1536 + 512 + h * 64), (char*)lds); }
            }
        }
        SEAM(pb + 4);
        if (EN(6) && IN(pb + 5)) REPS(6) { PH_BEGIN
            pg8::StaticOrder S; S.init(MTOK, 1024, G, bx);
            pg8::Gemm g{YA, (const bf16_t*)((const unsigned char*)WP + (size_t)l * 1024 * 1536), MTOK, 1024, 768}; pg8::EpiGate E{WSP(unsigned char, WS_G8), MB};
            pg8::gemm_phase<pg8::EpiGate, pg8::StaticOrder, true, true, true>((LAS unsigned char*)lds, g, S, E);
        }
        SEAM(pb + 5);
        if (EN(7) && IN(pb + 6)) { PH_BEGIN
            pg8::Gemm g{MB, (const bf16_t*)((const unsigned char*)WOUT + (size_t)l * 1024 * 1024), MTOK, 1024, 512}; pg8::StaticOrder S; S.init(MTOK, 1024, G, bx);
            pg8::EpiOut E{l == 0 ? x_in : (const float*)nullptr, X, MODL + 2048, 1.f / 32.f};
            pg8::gemm_phase<pg8::EpiOut, pg8::StaticOrder, true, true, true>((LAS unsigned char*)lds, g, S, E);
        }
        SEAM(pb + 6);
        if (EN(8) && IN(pb + 7)) REPS(8) { PH_BEGIN norm_mod_rows(nullptr, X, norm2_gain + l * DM, MODL + 3072, MODL + 4096, H, WSP(unsigned char, WS_HQ), WSP(float, WS_HS), gw, NGW, lane); }
        SEAM(pb + 7);
        if (EN(9) && IN(pb + 8)) REPS(9) { PH_BEGIN
            pg8::Gemm g{H, WQ + (size_t)l * 2048 * 1024, MTOK, 2048, 1024}; pg8::StaticOrder S; S.init(MTOK, 2048, G, bx);
            pg8::EpiPlain E{QP, 2048};
            pg8::gemm_phase<pg8::EpiPlain, pg8::StaticOrder, true, true>((LAS unsigned char*)lds, g, S, E);
        }
        SEAM(pb + 8);
        if (EN(10) && IN(pb + 9)) REPS(10) { PH_BEGIN
            u32x4 sreg[4];
            peer_topk_sload(vcu < 2048 ? vcu : 0, QP, sreg, tid);
            for (int it = vcu; it < 2048; it += G) peer_topk_item(it, it + G, QP, IDS, GW, (char*)lds, sreg, tid, wave, lane);
        }
        SEAM(pb + 9);
        const int ngrp = (G % 8 == 0) ? 8 : 1, cpg = G / ngrp, xg = vcu / cpg, spg = 8 / ngrp;
        if (EN(11) && IN(pb + 10)) REPS(11) { PH_BEGIN
            const int wg = (vcu - xg * cpg) * NWAVES + wave, wpg = cpg * NWAVES;
            for (int p = 0; p < spg; ++p) { const int s = xg * spg + p;
                peer_u_pass(s, wg, wpg, lane, WSP(unsigned char, WS_HQ), WSP(float, WS_HS), (const unsigned char*)PU + ((size_t)l * 8 + s) * 16384 * 128, IDS, WSP(bf16_t, WS_SP) + (size_t)s * MTOK * 128); }
        }
        SEAM(pb + 10);
        if (EN(12) && IN(pb + 11)) REPS(12) { PH_BEGIN
            const bf16_t* sp = WSP(bf16_t, WS_SP); float* gwp = GW;
            for (size_t i = (size_t)bx * (NWAVES * 64) + tid; i < (size_t)MTOK * 128 / 4; i += (size_t)G * NWAVES * 64) {
                f32x4 a = {0.f, 0.f, 0.f, 0.f};
#pragma unroll
                for (int s = 0; s < 8; ++s) { const u32x2 w = *(const u32x2*)(sp + (size_t)s * MTOK * 128 + i * 4); a += (f32x4){bf_lo(w.x), bf_hi(w.x), bf_lo(w.y), bf_hi(w.y)}; }
                const f32x4 g = *(const f32x4*)(gwp + i * 4);
                const float w0 = g[0] * gelu_tanh(a[0]), w1 = g[1] * gelu_tanh(a[1]), w2 = g[2] * gelu_tanh(a[2]), w3 = g[3] * gelu_tanh(a[3]);
                float am = __builtin_fmaxf(__builtin_fmaxf(__builtin_fabsf(w0), __builtin_fabsf(w1)), __builtin_fmaxf(__builtin_fabsf(w2), __builtin_fabsf(w3)));
                am = DPP_MAX(am, 0xB1); am = DPP_MAX(am, 0x4E); am = DPP_MAX(am, 0x141); am = DPP_MAX(am, 0x140);
                am = __builtin_fmaxf(am, __int_as_float(__builtin_amdgcn_ds_swizzle(__float_as_int(am), 0x401F)));
                am = __builtin_fmaxf(am, 1e-30f); const float inv = 127.f / am;
                WSP(unsigned, WS_W)[i] = pack4_i8(w0 * inv, w1 * inv, w2 * inv, w3 * inv);
                if ((i & 31) == 0) WSP(float, WS_WSC)[i >> 5] = am * (1.f / (127.f * PEER_SQV));
            }
        }
        SEAM(pb + 11);
        if (EN(13) && IN(pb + 12)) { PH_BEGIN
            const int wg = (vcu - xg * cpg) * NWAVES + wave, wpg = cpg * NWAVES;
            for (int p = 0; p < spg; ++p) { const int s = xg * spg + p;
                peer_v_pass(s, wg, wpg, lane, (const unsigned char*)PVt + ((size_t)l * 8 + s) * 16384 * 128, IDS, WSP(unsigned, WS_W), WSP(float, WS_WSC), X, MODL + 5120); }
        }
        SEAM(pb + 12);
#undef MODL
    }
    if (EN(14) && IN(1 + PPL * NLAYER)) { PH_BEGIN final_norm_rows(X, final_gain, *(float* const __attribute__((address_space(4)))*)(kp + 200), gw, NGW, lane); }
#undef IN
#undef SEAM
#undef x_in
#undef c_in
#undef w_ada
#undef b_ada
#undef norm1_gain
#undef w_in
#undef a_v_gain
#undef a_w_s
#undef a_b_s
#undef b_q_gain
#undef b_k_gain
#undef c_q_gain
#undef c_w_uq
#undef c_kv_gain
#undef c_w_ukv
#undef w_pa
#undef w_pb
#undef w_pc
#undef w_out
#undef norm2_gain
#undef peer_wq
#undef peer_sk
#undef peer_u
#undef peer_v
#undef final_gain
#undef MOD
#undef WIN
#undef WUQ
#undef WUKV
#undef WP
#undef WOUT
#undef WQ
#undef SUBK
#undef WSS
#undef cosB
#undef sinB
#undef cosC
#undef sinC
#undef PU
#undef PVt
#undef X
#undef H
#undef Z
#undef YA
#undef YB
#undef YC
#undef QB
#undef KB
#undef VB
#undef CQN
#undef CKVN
#undef QC
#undef KC
#undef VC
#undef MF
#undef MB
#undef QP
#undef IDS
#undef GW
}

extern "C" void kernel_launch(void* const* d_in, const int* in_sizes, int n_in, void* d_out, int out_size, void* d_ws, size_t ws_size, hipStream_t stream) {
    static int grid = 0;
    if (grid == 0) {
        if (n_in != 25 || out_size != MTOK * DM || ws_size < WS_END) { fprintf(stderr, "kernel_launch: unexpected shapes: n_in %d out %d ws %zu (need >= %zu)\n", n_in, out_size, ws_size, (size_t)WS_END); grid = -1; return; }
        int dev = 0, cus = 0, per_cu = 0;
        if (hipGetDevice(&dev) != hipSuccess || hipDeviceGetAttribute(&cus, hipDeviceAttributeMultiprocessorCount, dev) != hipSuccess) { grid = -1; return; }
        if (hipFuncSetAttribute((const void*)fwd, hipFuncAttributeMaxDynamicSharedMemorySize, LDS_BYTES) != hipSuccess) { fprintf(stderr, "kernel_launch: hipFuncSetAttribute failed\n"); grid = -1; return; }
        if (hipOccupancyMaxActiveBlocksPerMultiprocessor(&per_cu, (const void*)fwd, NWAVES * 64, LDS_BYTES) != hipSuccess || per_cu < 1) { fprintf(stderr, "kernel_launch: occupancy query says %d\n", per_cu); }
        (void)hipGetLastError();
        grid = cus;
    }
    if (grid < 0) return;
    if (hipMemsetAsync((char*)d_ws + WS_CTL, 0, CTL_ZERO_BYTES, stream) != hipSuccess) return;
    Args a{};
    for (int i = 0; i < 25; ++i) a.in[i] = (const float*)d_in[i];
    a.out = (float*)d_out; a.ws = (unsigned char*)d_ws;
#if MK_SPLIT
    for (int p = 0; p < N_PHASES; ++p) { a.ph_lo = p; a.ph_hi = p + 1; hipLaunchKernelGGL(fwd, dim3(grid), dim3(NWAVES * 64), LDS_BYTES, stream, a); }
#else
    a.ph_lo = 0; a.ph_hi = N_PHASES;
    hipLaunchKernelGGL(fwd, dim3(grid), dim3(NWAVES * 64), LDS_BYTES, stream, a);
#endif
    const hipError_t le = hipPeekAtLastError();
    if (le != hipSuccess) fprintf(stderr, "kernel_launch: launch failed: %s\n", hipGetErrorName(le));
}
```
